# Optimizing an MI355X kernel written in HIP

```python
import math
import jax, jax.numpy as jnp
from jax import lax
import numpy as np

D_MODEL = 1024
BATCH = 32
SEQ = 2048
DEPTH = 4

N_MEM = 256
HEAD_DIM = 64
N_DIL_HEADS = 12
DIL_WIDTH = N_DIL_HEADS * HEAD_DIM
DIL_PATTERNS = ((128, 1), (512, 4), (2048, 16))
BLOCK = 128
N_SGU_GROUPS = 12
SGU_GROUP_DIM = 64
SGU_WIDTH = N_SGU_GROUPS * SGU_GROUP_DIM
CHUNK = 128
N_MEM_HEADS = 4
MEM_WIDTH = N_MEM_HEADS * HEAD_DIM
MIX_WIDTH = DIL_WIDTH + MEM_WIDTH
D_FF = ((-(-8 * D_MODEL // 3) + 255) // 256) * 256
DN_ALPHA = (2 * DEPTH) ** 0.25
DN_BETA = (8 * DEPTH) ** -0.25
N_A = (DEPTH + 1) // 2
N_B = DEPTH // 2
IN_A = 3 * DIL_WIDTH + MEM_WIDTH
IN_B = 2 * SGU_WIDTH + MEM_WIDTH
LN_EPS = 1e-5

kernel_name = "hybrid_dilated_gmlp_memory_deepnorm"


def layer_norm(x, g, b):
    xf = x.astype(jnp.float32)
    mu = xf.mean(-1, keepdims=True)
    var = jnp.square(xf - mu).mean(-1, keepdims=True)
    y = (xf - mu) * lax.rsqrt(var + LN_EPS)
    return (y * g.astype(jnp.float32) + b.astype(jnp.float32)).astype(x.dtype)


def alibi_slopes(n):
    return jnp.exp2(-8.0 * (jnp.arange(n, dtype=jnp.float32) + 1.0) / n)


def band_pattern(q, k, v, slopes, window, dil):
    B, S, H, Dh = q.shape
    steps_max = window // dil
    L = S // dil
    n_blk = -(-L // BLOCK)
    Lp = n_blk * BLOCK
    def sub(t):
        return t.reshape(B, L, dil, H, Dh)
    qs = jnp.pad(sub(q), ((0, 0), (0, Lp - L), (0, 0), (0, 0), (0, 0)))
    qs = qs.reshape(B, n_blk, BLOCK, dil, H, Dh)
    def banded_keys(t):
        tp = jnp.pad(sub(t), ((0, 0), (BLOCK, Lp - L), (0, 0), (0, 0), (0, 0)))
        prev = tp[:, :Lp].reshape(B, n_blk, BLOCK, dil, H, Dh)
        cur = tp[:, BLOCK:].reshape(B, n_blk, BLOCK, dil, H, Dh)
        return jnp.concatenate([prev, cur], axis=2)
    kb = banded_keys(k)
    vb = banded_keys(v)
    s = jnp.einsum('bnqrhd,bnkrhd->bnrhqk', qs, kb).astype(jnp.float32) * (Dh ** -0.5)
    qi = jnp.arange(BLOCK)[:, None]
    ki = jnp.arange(2 * BLOCK)[None, :]
    steps = qi + BLOCK - ki
    key_idx = (jnp.arange(n_blk) * BLOCK)[:, None, None] - BLOCK + ki[None]
    valid = (steps >= 0) & (steps <= steps_max) & (key_idx >= 0)
    bias = -slopes[:, None, None] * (steps * dil).astype(jnp.float32)[None]
    s = s + bias[None, None, None]
    s = jnp.where(valid[None, :, None, None], s, -jnp.inf)
    m = s.max(-1, keepdims=True)
    p = jnp.exp(s - m)
    den = p.sum(-1)
    lse = m[..., 0] + jnp.log(den)
    o = jnp.einsum('bnrhqk,bnkrhd->bnqrhd', p.astype(v.dtype), vb)
    o = o / jnp.moveaxis(den, -1, 2)[..., None].astype(o.dtype)
    o = o.reshape(B, Lp, dil, H, Dh)[:, :L].reshape(B, S, H, Dh)
    lse = jnp.moveaxis(lse, -1, 2).reshape(B, Lp, dil, H)[:, :L].reshape(B, S, H)
    return o, lse


def dilated_attention(q, k, v):
    slopes = alibi_slopes(q.shape[2])
    outs, lses = [], []
    for window, dil in DIL_PATTERNS:
        o, lse = band_pattern(q, k, v, slopes, window, dil)
        outs.append(o)
        lses.append(lse)
    w = jax.nn.softmax(jnp.stack(lses, 0), axis=0).astype(q.dtype)
    return jnp.einsum('pbsh,pbshd->bshd', w, jnp.stack(outs, 0))


def causal_chunk_sgu(u, v, ln_g, ln_b, w_s, b_s):
    B, S, _ = v.shape
    v = layer_norm(v, ln_g, ln_b)
    vc = v.reshape(B, S // CHUNK, CHUNK, N_SGU_GROUPS, SGU_GROUP_DIM)
    ws = w_s * jnp.tril(jnp.ones((CHUNK, CHUNK), w_s.dtype))
    mixed = jnp.einsum('gts,bnsgc->bntgc', ws, vc) + b_s.T[None, None, :, :, None]
    return u * mixed.reshape(B, S, SGU_WIDTH)


def memory_attention(qm, mk, mv):
    s = jnp.einsum('bshd,bmhd->bhsm', qm, mk).astype(jnp.float32) * (HEAD_DIM ** -0.5)
    p = jax.nn.softmax(s, axis=-1).astype(mv.dtype)
    return jnp.einsum('bhsm,bmhd->bshd', p, mv)


def setup_inputs(seed: int = 0) -> dict:
    key = jax.random.key(seed)
    ks = jax.random.split(key, 18)
    f32 = jnp.float32
    D = D_MODEL
    def nrm(k, shape, scale):
        return jax.random.normal(k, shape, f32) * scale
    return {
        "x": nrm(ks[0], (BATCH, SEQ, D), 1.0),
        "mem": nrm(ks[1], (BATCH, N_MEM, D), 1.0),
        "a_w_in": nrm(ks[2], (N_A, D, IN_A), D ** -0.5),
        "b_w_in": nrm(ks[3], (N_B, D, IN_B), D ** -0.5),
        "sgu_ln_g": 1.0 + nrm(ks[4], (N_B, SGU_WIDTH), 0.02),
        "sgu_ln_b": nrm(ks[5], (N_B, SGU_WIDTH), 0.02),
        "sgu_w_s": nrm(ks[6], (N_B, N_SGU_GROUPS, CHUNK, CHUNK), CHUNK ** -0.5),
        "sgu_b_s": 1.0 + nrm(ks[7], (N_B, N_SGU_GROUPS, CHUNK), 0.02),
        "w_mem_kv": nrm(ks[8], (DEPTH, D, 2 * MEM_WIDTH), D ** -0.5),
        "w_out": nrm(ks[9], (DEPTH, MIX_WIDTH, D), DN_BETA * MIX_WIDTH ** -0.5),
        "ln_mix_g": 1.0 + nrm(ks[10], (DEPTH, D), 0.02),
        "ln_mix_b": nrm(ks[11], (DEPTH, D), 0.02),
        "w_gate": nrm(ks[12], (DEPTH, D, D_FF), D ** -0.5),
        "w_up": nrm(ks[13], (DEPTH, D, D_FF), D ** -0.5),
        "w_down": nrm(ks[14], (DEPTH, D_FF, D), DN_BETA * D_FF ** -0.5),
        "ln_ffn_g": 1.0 + nrm(ks[15], (DEPTH, D), 0.02),
        "ln_ffn_b": nrm(ks[16], (DEPTH, D), 0.02),
    }


def reference(x, mem, a_w_in, b_w_in, sgu_ln_g, sgu_ln_b, sgu_w_s, sgu_b_s, w_mem_kv, w_out,
              ln_mix_g, ln_mix_b, w_gate, w_up, w_down, ln_ffn_g, ln_ffn_b):
    B, S, _ = x.shape
    for i in range(DEPTH):
        j = i // 2
        mk, mv = jnp.split(mem @ w_mem_kv[i], 2, axis=-1)
        mk = mk.reshape(B, N_MEM, N_MEM_HEADS, HEAD_DIM)
        mv = mv.reshape(B, N_MEM, N_MEM_HEADS, HEAD_DIM)
        if i % 2 == 0:
            h = x @ a_w_in[j]
            q, k, v, qm = jnp.split(h, [DIL_WIDTH, 2 * DIL_WIDTH, 3 * DIL_WIDTH], axis=-1)
            hs = (B, S, N_DIL_HEADS, HEAD_DIM)
            mix = dilated_attention(q.reshape(hs), k.reshape(hs), v.reshape(hs)).reshape(B, S, DIL_WIDTH)
        else:
            h = x @ b_w_in[j]
            u, v, qm = jnp.split(h, [SGU_WIDTH, 2 * SGU_WIDTH], axis=-1)
            mix = causal_chunk_sgu(jax.nn.gelu(u), jax.nn.gelu(v), sgu_ln_g[j], sgu_ln_b[j],
                                   sgu_w_s[j], sgu_b_s[j])
        mo = memory_attention(qm.reshape(B, S, N_MEM_HEADS, HEAD_DIM), mk, mv).reshape(B, S, MEM_WIDTH)
        y = jnp.concatenate([mix, mo], axis=-1) @ w_out[i]
        x = layer_norm(DN_ALPHA * x + y, ln_mix_g[i], ln_mix_b[i])
        f = (jax.nn.silu(x @ w_gate[i]) * (x @ w_up[i])) @ w_down[i]
        x = layer_norm(DN_ALPHA * x + f, ln_ffn_g[i], ln_ffn_b[i])
    return x
```

```cpp
#include <hip/hip_runtime.h>
#include <cstdio>
#include <cstdint>
namespace pg8 {
#define PG8_LAS __attribute__((address_space(3)))
typedef unsigned short bf16_t;
typedef short bf16x8 __attribute__((ext_vector_type(8)));
typedef float f32x4 __attribute__((ext_vector_type(4)));
typedef unsigned u32x4 __attribute__((ext_vector_type(4)));
constexpr int BM = 256, BK = 64, HALF = 128, HTB = HALF * BK * 2  , STAGE_BYTES = 8 * HTB, NXCD = 8, WGM = 8;

__host__ __device__ __forceinline__ int lds_byte(int r, int c) { const int st = (r >> 4) * 2 + (c >> 5), rr = r & 15, cc = c & 31, ob = rr * 64 + cc * 2; return st * 1024 + (ob ^ (((ob >> 9) & 1) << 5)); }
__host__ __device__ __forceinline__ void stage_rc(int b, int& R, int& C) { const int st = b / 1024, sb = b % 1024, swz = sb ^ (((sb >> 9) & 1) << 5); R = (st >> 1) * 16 + swz / 64; C = (st & 1) * 32 + (swz % 64) / 2; }
__host__ __device__ __forceinline__ int perm32(int rho) { const int n = rho >> 4, i = rho & 15; return 8 * (i >> 2) + 4 * n + (i & 3); }

struct Unit { int pm, pn; };
struct Gemm { const bf16_t* A; const bf16_t* Bt; int M, N, K; };

struct StaticOrder {
    int nM, nN, nwg, G, c;
    __host__ __device__ void init(int M, int N, int G_, int c_) { nM = M / BM; nN = N / BM; nwg = nM * nN; G = G_; c = c_; }
    __host__ __device__ bool next(int i, Unit& u) const {
        const long L = (long)i * G + c; if (L >= nwg) return false;
        int wgid = (int)L; { const int q = nwg / NXCD, r = nwg % NXCD, xcd = wgid % NXCD, off = wgid / NXCD; wgid = (xcd < r ? xcd * (q + 1) : r * (q + 1) + (xcd - r) * q) + off; }
        const int nig = WGM * nN, gid = wgid / nig, fm = gid * WGM, gsz = (nM - fm) < WGM ? (nM - fm) : WGM;
        u.pm = fm + ((wgid % nig) % gsz); u.pn = (wgid % nig) / gsz; return true;
    }
    __device__ __forceinline__ void a_ready(const Unit&) const {}
    __device__ __forceinline__ void done(const Unit&) const {}
};

__device__ __forceinline__ unsigned cvt_pk_bf16(float lo, float hi) { unsigned r; asm volatile("v_cvt_pk_bf16_f32 %0, %1, %2" : "=v"(r) : "v"(lo), "v"(hi)); return r; }
typedef float f32x2 __attribute__((ext_vector_type(2)));
__device__ __forceinline__ float sigm_fast(float z) { return __builtin_amdgcn_rcpf(1.0f + __builtin_amdgcn_exp2f(-1.4426950408889634f * z)); }
__device__ __forceinline__ float gelu_tanh(float x) { const float z = 1.5957691216057308f * (x + 0.044715f * x * x * x); return x * sigm_fast(z); }
__device__ __forceinline__ float silu_f(float x) { return x * sigm_fast(x); }
struct EpiStore {
    static constexpr bool PERM = true, AFTER_DRAIN = false;
    bf16_t* O; int ldc; int gelu_tiles;
    __device__ __forceinline__ void operator()(const f32x4 (&acc)[2][2][4][2], const Unit& u, int wr, int wc, int fr, int fq) const {
        const int row0 = u.pm * BM + wr * 64 + fr, col0 = u.pn * BM + wc * 32 + 8 * fq; const bool g = u.pn < gelu_tiles;
#pragma unroll
        for (int ai = 0; ai < 2; ++ai)
#pragma unroll
            for (int m = 0; m < 4; ++m) { bf16_t* rowp = O + (size_t)(row0 + ai * HALF + m * 16) * ldc + col0;
#pragma unroll
                for (int bj = 0; bj < 2; ++bj) { f32x4 v0 = acc[ai][bj][m][0], v1 = acc[ai][bj][m][1];
                    if (g) {
#pragma unroll
                        for (int e = 0; e < 4; ++e) { v0[e] = gelu_tanh(v0[e]); v1[e] = gelu_tanh(v1[e]); } }
                    u32x4 w; w.x = cvt_pk_bf16(v0[0], v0[1]); w.y = cvt_pk_bf16(v0[2], v0[3]); w.z = cvt_pk_bf16(v1[0], v1[1]); w.w = cvt_pk_bf16(v1[2], v1[3]);
                    *(u32x4*)(rowp + bj * HALF) = w; } }
    }
};
struct EpiSwiGLU {
    static constexpr bool PERM = true, AFTER_DRAIN = false;
    bf16_t* O; int ldc;
    __device__ __forceinline__ void operator()(const f32x4 (&acc)[2][2][4][2], const Unit& u, int wr, int wc, int fr, int fq) const {
        const int row0 = u.pm * BM + wr * 64 + fr, col0 = u.pn * HALF + wc * 32 + 8 * fq;
#pragma unroll
        for (int ai = 0; ai < 2; ++ai)
#pragma unroll
            for (int m = 0; m < 4; ++m) { bf16_t* rowp = O + (size_t)(row0 + ai * HALF + m * 16) * ldc + col0;
                f32x4 h0, h1;
#pragma unroll
                for (int e = 0; e < 4; ++e) { h0[e] = silu_f(acc[ai][0][m][0][e]) * acc[ai][1][m][0][e]; h1[e] = silu_f(acc[ai][0][m][1][e]) * acc[ai][1][m][1][e]; }
                u32x4 w; w.x = cvt_pk_bf16(h0[0], h0[1]); w.y = cvt_pk_bf16(h0[2], h0[3]); w.z = cvt_pk_bf16(h1[0], h1[1]); w.w = cvt_pk_bf16(h1[2], h1[3]);
                *(u32x4*)rowp = w; }
    }
};
struct EpiResid {
    static constexpr bool PERM = true, AFTER_DRAIN = false;
    const float* base; float* out; int ldc; float alpha;
    __device__ __forceinline__ void operator()(const f32x4 (&acc)[2][2][4][2], const Unit& u, int wr, int wc, int fr, int fq) const {
        const int row0 = u.pm * BM + wr * 64 + fr, col0 = u.pn * BM + wc * 32 + 8 * fq;
#pragma unroll
        for (int ai = 0; ai < 2; ++ai)
#pragma unroll
            for (int m = 0; m < 4; ++m) { const size_t off = (size_t)(row0 + ai * HALF + m * 16) * ldc + col0;
#pragma unroll
                for (int bj = 0; bj < 2; ++bj) { const f32x4 b0 = *(const f32x4*)(base + off + bj * HALF), b1 = *(const f32x4*)(base + off + bj * HALF + 4);
                    *(f32x4*)(out + off + bj * HALF) = b0 * alpha + acc[ai][bj][m][0]; *(f32x4*)(out + off + bj * HALF + 4) = b1 * alpha + acc[ai][bj][m][1]; } }
    }
};
template <class Epi, class Sched, bool ALIGN_EPI = false, bool SP2 = false>
__device__ __forceinline__ void gemm_phase(PG8_LAS unsigned char* lds, const Gemm g, const Sched& S, const Epi& E) {
    int tid_ = threadIdx.x; asm volatile("" : "+v"(tid_)); const int tid = tid_, wid = __builtin_amdgcn_readfirstlane(tid >> 6), lane = tid & 63, wr = wid >> 2, wc = wid & 3, fr = lane & 15, fq = lane >> 4;
    const int K = g.K, nt = K / BK;
    unsigned voffA[2], voffB[2];
#pragma unroll
    for (int i = 0; i < 2; ++i) { int R, C; stage_rc(tid * 16 + i * 8192, R, C); const int Rb = Epi::PERM ? ((R & ~31) + perm32(R & 31)) : R;
        voffA[i] = (unsigned)(R * K + C) * 2u; voffB[i] = (unsigned)(Rb * K + C) * 2u; }
    const size_t kstep = (size_t)(BK * 2);
    const size_t hstep = (size_t)HALF * K * 2;
    const size_t tstep = 2 * hstep;
    const unsigned ldsw = (unsigned)wid * 1024u;
    const int aoff = lds_byte(wr * 64 + fr, fq * 8), boff = lds_byte(wc * 32 + fr, fq * 8);
#define PG8_SA(b, h) (((b) * 2 + (h)) * HTB)
#define PG8_SB(b, h) ((4 + (b) * 2 + (h)) * HTB)
#define PG8_STAGE(bufoff, gbase, voff) do { _Pragma("unroll") for (int _i = 0; _i < 2; ++_i) \
        __builtin_amdgcn_global_load_lds((const unsigned*)((const char*)(gbase) + (voff)[_i]), (PG8_LAS unsigned*)(lds + (bufoff) + ldsw + _i * 8192), 16, 0, 0); } while (0)
#define PG8_LDA(dst, b, h) do { _Pragma("unroll") for (int m = 0; m < 4; ++m) _Pragma("unroll") for (int k = 0; k < 2; ++k) dst[m][k] = *(const PG8_LAS bf16x8*)(lds + PG8_SA(b, h) + aoff + m * 2048 + k * 1024); } while (0)
#define PG8_LDB(dst, b, h) do { _Pragma("unroll") for (int n = 0; n < 2; ++n) _Pragma("unroll") for (int k = 0; k < 2; ++k) dst[n][k] = *(const PG8_LAS bf16x8*)(lds + PG8_SB(b, h) + boff + n * 2048 + k * 1024); } while (0)
#define PG8_MMA(ai, bj, At, Bt) do { __builtin_amdgcn_s_setprio(1); _Pragma("unroll") for (int m = 0; m < 4; ++m) _Pragma("unroll") for (int n = 0; n < 2; ++n) _Pragma("unroll") for (int k = 0; k < 2; ++k) \
        acc[ai][bj][m][n] = __builtin_amdgcn_mfma_f32_16x16x32_bf16(Bt[n][k], At[m][k], acc[ai][bj][m][n], 0, 0, 0); __builtin_amdgcn_s_setprio(0); } while (0)
#define PG8_WAIT_V(n) asm volatile("s_waitcnt vmcnt(" #n ")" ::: "memory")
#define PG8_WAIT_L(n) asm volatile("s_waitcnt lgkmcnt(" #n ")" ::: "memory")
#define PG8_BAR __builtin_amdgcn_s_barrier()
#define PG8_SCHED __builtin_amdgcn_sched_barrier(0)
    Unit cur, nxt; int ui = 0;
    if (!S.next(0, cur)) return;
    f32x4 acc[2][2][4][2];
#pragma unroll
    for (int a = 0; a < 2; ++a)
#pragma unroll
        for (int b = 0; b < 2; ++b)
#pragma unroll
            for (int m = 0; m < 4; ++m)
#pragma unroll
                for (int n = 0; n < 2; ++n) acc[a][b][m][n] = (f32x4){0.f, 0.f, 0.f, 0.f};
    bf16x8 At[4][2], B0[2][2], B1[2][2];
    const char* cA = (const char*)g.A + (size_t)cur.pm * tstep; const char* cB = (const char*)g.Bt + (size_t)cur.pn * tstep;
    S.a_ready(cur);
    if constexpr (SP2) {
        PG8_STAGE(PG8_SB(0, 0), cB, voffB); PG8_STAGE(PG8_SB(0, 1), cB + hstep, voffB); PG8_STAGE(PG8_SA(0, 0), cA, voffA); PG8_STAGE(PG8_SA(0, 1), cA + hstep, voffA);
        if (wr == 1) PG8_BAR;
        PG8_WAIT_V(2); PG8_BAR;
        PG8_STAGE(PG8_SB(1, 0), cB + kstep, voffB); PG8_STAGE(PG8_SA(1, 0), cA + kstep, voffA); PG8_STAGE(PG8_SB(1, 1), cB + hstep + kstep, voffB);
        PG8_WAIT_V(6); PG8_BAR;
    } else {
        PG8_STAGE(PG8_SB(0, 0), cB, voffB); PG8_STAGE(PG8_SA(0, 0), cA, voffA); PG8_STAGE(PG8_SB(0, 1), cB + hstep, voffB); PG8_STAGE(PG8_SA(0, 1), cA + hstep, voffA);
        if (wr == 1) PG8_BAR;
        PG8_WAIT_V(4); PG8_BAR;
        PG8_STAGE(PG8_SB(1, 0), cB + kstep, voffB); PG8_STAGE(PG8_SA(1, 0), cA + kstep, voffA); PG8_STAGE(PG8_SB(1, 1), cB + hstep + kstep, voffB);
        PG8_WAIT_V(6); PG8_BAR;
    }
    for (;;) {
        const bool has_next = S.next(ui + 1, nxt);
        const char* nA = has_next ? (const char*)g.A + (size_t)nxt.pm * tstep : cA; const char* nB = has_next ? (const char*)g.Bt + (size_t)nxt.pn * tstep : cB;
        for (int t = 0; t < nt; t += 2) {
            const bool last = (t == nt - 2);
            const char* a1 = cA + (size_t)(t + 1) * kstep;
            const char* a2 = last ? nA : cA + (size_t)(t + 2) * kstep; const char* b2 = last ? nB : cB + (size_t)(t + 2) * kstep;
            const char* a3 = a2 + kstep; const char* b3 = b2 + kstep;
            if (last && has_next) S.a_ready(nxt);
            if constexpr (SP2) {
            PG8_LDB(B0, 0, 0); PG8_LDB(B1, 0, 1); PG8_SCHED; PG8_LDA(At, 0, 0); PG8_STAGE(PG8_SA(1, 1), a1 + hstep, voffA);
            PG8_WAIT_V(8); PG8_WAIT_L(0); PG8_BAR; PG8_MMA(0, 0, At, B0); PG8_MMA(0, 1, At, B1); PG8_BAR; PG8_SCHED;
            PG8_LDA(At, 0, 1); PG8_STAGE(PG8_SB(0, 0), b2, voffB); PG8_STAGE(PG8_SB(0, 1), b2 + hstep, voffB); PG8_STAGE(PG8_SA(0, 0), a2, voffA);
            PG8_WAIT_V(8); PG8_WAIT_L(0); PG8_BAR; PG8_MMA(1, 0, At, B0); PG8_MMA(1, 1, At, B1); PG8_BAR; PG8_SCHED;
            PG8_LDB(B0, 1, 0); PG8_LDB(B1, 1, 1); PG8_SCHED; PG8_LDA(At, 1, 0); PG8_STAGE(PG8_SA(0, 1), a2 + hstep, voffA);
            PG8_WAIT_V(8); PG8_WAIT_L(0); PG8_BAR; PG8_MMA(0, 0, At, B0); PG8_MMA(0, 1, At, B1); PG8_BAR; PG8_SCHED;
            PG8_LDA(At, 1, 1); PG8_STAGE(PG8_SB(1, 0), b3, voffB); PG8_STAGE(PG8_SB(1, 1), b3 + hstep, voffB); PG8_STAGE(PG8_SA(1, 0), a3, voffA);
            PG8_WAIT_V(8); PG8_WAIT_L(0); PG8_BAR; PG8_MMA(1, 0, At, B0); PG8_MMA(1, 1, At, B1); PG8_BAR; PG8_SCHED;
            } else {
            PG8_LDB(B0, 0, 0); PG8_SCHED; PG8_LDA(At, 0, 0); PG8_STAGE(PG8_SA(1, 1), a1 + hstep, voffA);
            PG8_WAIT_L(8); PG8_BAR; PG8_WAIT_L(0); PG8_MMA(0, 0, At, B0); PG8_BAR; PG8_SCHED;
            PG8_LDB(B1, 0, 1); PG8_STAGE(PG8_SB(0, 0), b2, voffB);
            PG8_BAR; PG8_WAIT_L(0); PG8_MMA(0, 1, At, B1); PG8_BAR;
            PG8_LDA(At, 0, 1); PG8_STAGE(PG8_SA(0, 0), a2, voffA);
            PG8_BAR; PG8_WAIT_L(0); PG8_MMA(1, 0, At, B0); PG8_BAR; PG8_SCHED;
            PG8_STAGE(PG8_SB(0, 1), b2 + hstep, voffB);
            PG8_WAIT_V(6); PG8_BAR; PG8_MMA(1, 1, At, B1); PG8_BAR;
            PG8_LDB(B0, 1, 0); PG8_SCHED; PG8_LDA(At, 1, 0); PG8_STAGE(PG8_SA(0, 1), a2 + hstep, voffA);
            PG8_WAIT_L(8); PG8_BAR; PG8_WAIT_L(0); PG8_MMA(0, 0, At, B0); PG8_BAR; PG8_SCHED;
            PG8_LDB(B1, 1, 1); PG8_STAGE(PG8_SB(1, 0), b3, voffB);
            PG8_BAR; PG8_WAIT_L(0); PG8_MMA(0, 1, At, B1); PG8_BAR;
            PG8_LDA(At, 1, 1); PG8_STAGE(PG8_SA(1, 0), a3, voffA);
            PG8_BAR; PG8_WAIT_L(0); PG8_MMA(1, 0, At, B0); PG8_BAR; PG8_SCHED;
            PG8_STAGE(PG8_SB(1, 1), b3 + hstep, voffB);
            PG8_WAIT_V(6); PG8_BAR; PG8_MMA(1, 1, At, B1); PG8_BAR;
            }
        }
        if constexpr (ALIGN_EPI) { if (wr == 0) PG8_BAR; }
        if constexpr (!Epi::AFTER_DRAIN) { E(acc, cur, wr, wc, fr, fq); S.done(cur); }
        if (!has_next) break;
#pragma unroll
        for (int a = 0; a < 2; ++a)
#pragma unroll
            for (int b = 0; b < 2; ++b)
#pragma unroll
                for (int m = 0; m < 4; ++m)
#pragma unroll
                    for (int n = 0; n < 2; ++n) acc[a][b][m][n] = (f32x4){0.f, 0.f, 0.f, 0.f};
        cur = nxt; cA = nA; cB = nB; ++ui;
        if constexpr (ALIGN_EPI) { if (wr == 1) PG8_BAR; }
    }
    PG8_WAIT_V(0);
    if constexpr (!ALIGN_EPI) { if (wr == 0) PG8_BAR; }
    PG8_BAR;
    if constexpr (Epi::AFTER_DRAIN) { E.fused(acc, cur, wr, wc, fr, fq, lds, wid, lane); S.done(cur); }
#undef PG8_SA
#undef PG8_SB
#undef PG8_STAGE
#undef PG8_LDA
#undef PG8_LDB
#undef PG8_MMA
#undef PG8_WAIT_V
#undef PG8_WAIT_L
#undef PG8_BAR
#undef PG8_SCHED
}
}
#include <hip/hip_cooperative_groups.h>
namespace cg = cooperative_groups;
#define LAS __attribute__((address_space(3)))
typedef unsigned short bf16;
typedef float f32x4 __attribute__((ext_vector_type(4)));
typedef short bf16x8 __attribute__((ext_vector_type(8)));
typedef short s16x4 __attribute__((ext_vector_type(4)));
typedef unsigned u32x4 __attribute__((ext_vector_type(4)));
typedef unsigned u32x2 __attribute__((ext_vector_type(2)));
typedef short v4i16_t __attribute__((ext_vector_type(4)));

constexpr int NWAVES = 8, NTHR = 512;
constexpr int BATCH = 32, SEQ = 2048, D = 1024, M = BATCH * SEQ, NMEM = 256, MMEM = BATCH * NMEM;
constexpr int INA = 2560, INB = 1792, FF = 2816, FF2 = 5632, DEPTH = 4, DILW = 768;
constexpr float LN_EPS = 1e-5f, DN_ALPHA = 1.6817928305074290f  , LOG2E = 1.4426950408889634f;
constexpr size_t MiB = 1u << 20;
constexpr size_t WS_WINA = 1 * MiB;
constexpr size_t WS_WINB = WS_WINA + 10 * MiB;
constexpr size_t WS_WMKV = WS_WINB + 7 * MiB;
constexpr size_t WS_WOUT = WS_WMKV + 4 * MiB;
constexpr size_t WS_WFF = WS_WOUT + 8 * MiB;
constexpr size_t WS_WDN = WS_WFF + 44 * MiB;
constexpr size_t WS_WS = WS_WDN + 22 * MiB;
constexpr size_t WS_MEMB = WS_WS + 1 * MiB;
constexpr size_t WS_MKV = WS_MEMB + 16 * MiB;
constexpr size_t WS_XB = WS_MKV + 32 * MiB;
constexpr size_t WS_H = WS_XB + 128 * MiB;
constexpr size_t WS_MIX = WS_H + 320 * MiB;
constexpr size_t WS_PART = WS_MIX + 128 * MiB;
constexpr size_t WS_LSE = WS_PART + 192 * MiB;
constexpr size_t WS_END = WS_LSE + 9 * MiB;
static_assert(WS_H + (size_t)M * FF * 2 <= WS_PART, "HID overlay");
static_assert(WS_END <= 1024 * MiB, "ws");
constexpr int LDS_BYTES = 147456;

__device__ __forceinline__ unsigned f2bf(float f) { unsigned u = __builtin_bit_cast(unsigned, f); return (u + 0x7fffu + ((u >> 16) & 1u)) >> 16; }
__device__ __forceinline__ unsigned pk2(float lo, float hi) { return pg8::cvt_pk_bf16(lo, hi); }
__device__ __forceinline__ float bflo(unsigned w) { return __builtin_bit_cast(float, w << 16); }
__device__ __forceinline__ float bfhi(unsigned w) { return __builtin_bit_cast(float, w & 0xffff0000u); }
__device__ __forceinline__ int otid() { int t = threadIdx.x; asm volatile("" : "+v"(t)); return t; }
#define TIDS() const int tid = otid(), lane = tid & 63, wave = __builtin_amdgcn_readfirstlane(tid >> 6)
__device__ __forceinline__ float wave_sum(float v) {
#pragma unroll
    for (int o = 1; o < 64; o <<= 1) v += __shfl_xor(v, o);
    return v;
}
__device__ __forceinline__ s16x4 tr_read(const LAS unsigned char* p) { return __builtin_bit_cast(s16x4, __builtin_amdgcn_ds_read_tr16_b64_v4i16((LAS v4i16_t*)p)); }
__device__ __forceinline__ bf16x8 cat4(s16x4 a, s16x4 b) { bf16x8 r; r[0] = a[0]; r[1] = a[1]; r[2] = a[2]; r[3] = a[3]; r[4] = b[0]; r[5] = b[1]; r[6] = b[2]; r[7] = b[3]; return r; }

__device__ __forceinline__ void transpose_item(const float* W, int K, int N, bf16* dst, LAS float* scr, int k0, int n0, int lane) {
#pragma unroll 8
    for (int i = 0; i < 32; ++i) { const int kk = 2 * i + (lane >> 5); scr[kk * 33 + (lane & 31)] = W[(size_t)(k0 + kk) * N + n0 + (lane & 31)]; }
    asm volatile("s_waitcnt lgkmcnt(0)" ::: "memory");
    const int c = lane & 7;
#pragma unroll
    for (int j = 0; j < 4; ++j) { const int n = (lane >> 3) + 8 * j; const LAS float* s = scr + (8 * c) * 33 + n;
        u32x4 o; o.x = pk2(s[0 * 33], s[1 * 33]); o.y = pk2(s[2 * 33], s[3 * 33]); o.z = pk2(s[4 * 33], s[5 * 33]); o.w = pk2(s[6 * 33], s[7 * 33]);
        *(u32x4*)(dst + (size_t)n * K + k0 + 8 * c) = o; }
    asm volatile("s_waitcnt lgkmcnt(0)" ::: "memory");
}
struct Ptrs {
    const float *x, *mem, *a_w_in, *b_w_in, *sgu_g, *sgu_b, *sgu_ws, *sgu_bs, *w_mkv, *w_out, *ln1g, *ln1b, *w_gate, *w_up, *w_down, *ln2g, *ln2b;
    float* out; unsigned char* ws;
};
typedef __attribute__((address_space(4))) const unsigned char* kargp_t;
template <class T> __device__ __forceinline__ T karg(kargp_t kp, int off) { return *(const volatile __attribute__((address_space(4))) T*)(kp + off); }
#define KP(field) karg<decltype(Ptrs::field)>(kp, (int)__builtin_offsetof(Ptrs, field))
__device__ __forceinline__ void prologue(kargp_t kp, LAS unsigned char* lds, int tid, int lane, int wave) {
    LAS float* scr = (LAS float*)(lds + wave * 16384);
    const int gw = blockIdx.x * NWAVES + wave, NGW = gridDim.x * NWAVES;
    constexpr int I_A = 16 * 80, I_B = 16 * 56, I_M = 16 * 16, I_O = 16 * 32, I_G = 16 * 88, I_D = 44 * 32;
    constexpr int C_A = 2 * I_A, C_B = C_A + 2 * I_B, C_M = C_B + 4 * I_M, C_O = C_M + 4 * I_O, C_G = C_O + 8 * I_G, C_D = C_G + 4 * I_D;
    unsigned char* ws = KP(ws);
    for (int it = gw; it < C_D; it += NGW) {
        if (it < C_A) { const int j = it / I_A, r = it % I_A, kb = r / 80, nb = r % 80;
            transpose_item(KP(a_w_in) + (size_t)j * D * INA, D, INA, (bf16*)(ws + WS_WINA) + ((size_t)j * INA + 32 * nb) * D, scr, 64 * kb, 32 * nb, lane); }
        else if (it < C_B) { const int q = it - C_A, j = q / I_B, r = q % I_B, kb = r / 56, nb = r % 56;
            transpose_item(KP(b_w_in) + (size_t)j * D * INB, D, INB, (bf16*)(ws + WS_WINB) + ((size_t)j * INB + 32 * nb) * D, scr, 64 * kb, 32 * nb, lane); }
        else if (it < C_M) { const int q = it - C_B, j = q / I_M, r = q % I_M, kb = r / 16, nb = r % 16;
            transpose_item(KP(w_mkv) + (size_t)j * D * 512, D, 512, (bf16*)(ws + WS_WMKV) + ((size_t)j * 512 + 32 * nb) * D, scr, 64 * kb, 32 * nb, lane); }
        else if (it < C_O) { const int q = it - C_M, j = q / I_O, r = q % I_O, kb = r / 32, nb = r % 32;
            transpose_item(KP(w_out) + (size_t)j * D * D, D, D, (bf16*)(ws + WS_WOUT) + ((size_t)j * D + 32 * nb) * D, scr, 64 * kb, 32 * nb, lane); }
        else if (it < C_G) { const int q = it - C_O, jj = q / I_G, r = q % I_G, kb = r / 88, nb = r % 88, j = jj >> 1, up = jj & 1;
            const int n0 = 32 * nb, drow = 256 * (n0 >> 7) + (n0 & 127) + 128 * up;
            transpose_item((up ? KP(w_up) : KP(w_gate)) + (size_t)j * D * FF, D, FF, (bf16*)(ws + WS_WFF) + ((size_t)j * FF2 + drow) * D, scr, 64 * kb, n0, lane); }
        else { const int q = it - C_G, j = q / I_D, r = q % I_D, kb = r / 32, nb = r % 32;
            transpose_item(KP(w_down) + (size_t)j * FF * D, FF, D, (bf16*)(ws + WS_WDN) + ((size_t)j * D + 32 * nb) * FF, scr, 64 * kb, 32 * nb, lane); }
    }
    const size_t gt = (size_t)blockIdx.x * NTHR + tid, NGT = (size_t)gridDim.x * NTHR;
    const float* sgu_ws = KP(sgu_ws);
    for (size_t i = gt; i < (size_t)2 * 12 * 128 * 128 / 8; i += NGT) { const size_t e = i * 8; const int s0 = (int)(e & 127), t = (int)((e >> 7) & 127);
        const f32x4 a = *(const f32x4*)(sgu_ws + e), b = *(const f32x4*)(sgu_ws + e + 4); float v[8] = {a.x, a.y, a.z, a.w, b.x, b.y, b.z, b.w};
#pragma unroll
        for (int k = 0; k < 8; ++k) v[k] = (s0 + k <= t) ? v[k] : 0.f;
        u32x4 o; o.x = pk2(v[0], v[1]); o.y = pk2(v[2], v[3]); o.z = pk2(v[4], v[5]); o.w = pk2(v[6], v[7]); *(u32x4*)((bf16*)(ws + WS_WS) + e) = o; }
    const float* xin = KP(x); const float* memin = KP(mem);
    for (size_t i = gt; i < (size_t)M * D / 8; i += NGT) { const f32x4 a = *(const f32x4*)(xin + i * 8), b = *(const f32x4*)(xin + i * 8 + 4);
        u32x4 o; o.x = pk2(a.x, a.y); o.y = pk2(a.z, a.w); o.z = pk2(b.x, b.y); o.w = pk2(b.z, b.w); *(u32x4*)((bf16*)(ws + WS_XB) + i * 8) = o; }
    for (size_t i = gt; i < (size_t)MMEM * D / 8; i += NGT) { const f32x4 a = *(const f32x4*)(memin + i * 8), b = *(const f32x4*)(memin + i * 8 + 4);
        u32x4 o; o.x = pk2(a.x, a.y); o.y = pk2(a.z, a.w); o.z = pk2(b.x, b.y); o.w = pk2(b.z, b.w); *(u32x4*)((bf16*)(ws + WS_MEMB) + i * 8) = o; }
}

__device__ __forceinline__ void ln_phase(float* xio, const float* g, const float* b, bf16* xb, int lane, int wave) {
    const int gw = blockIdx.x * NWAVES + wave, NGW = gridDim.x * NWAVES;
    f32x4 gv[4], bv[4];
#pragma unroll
    for (int j = 0; j < 4; ++j) { gv[j] = *(const f32x4*)(g + 256 * j + 4 * lane); bv[j] = *(const f32x4*)(b + 256 * j + 4 * lane); }
    for (int m = gw; m < M; m += NGW) {
        float* xr = xio + (size_t)m * D + 4 * lane; f32x4 v[4]; float s = 0.f;
#pragma unroll
        for (int j = 0; j < 4; ++j) { v[j] = *(const f32x4*)(xr + 256 * j); s += (v[j].x + v[j].y) + (v[j].z + v[j].w); }
        const float mean = wave_sum(s) * (1.f / D); float s2 = 0.f;
#pragma unroll
        for (int j = 0; j < 4; ++j) { v[j] = v[j] - mean; s2 += (v[j].x * v[j].x + v[j].y * v[j].y) + (v[j].z * v[j].z + v[j].w * v[j].w); }
        const float rstd = 1.f / sqrtf(wave_sum(s2) * (1.f / D) + LN_EPS);
#pragma unroll
        for (int j = 0; j < 4; ++j) { const f32x4 y = v[j] * rstd * gv[j] + bv[j]; *(f32x4*)(xr + 256 * j) = y;
            if (xb) { u32x2 o; o.x = pk2(y.x, y.y); o.y = pk2(y.z, y.w); *(u32x2*)(xb + (size_t)m * D + 256 * j + 4 * lane) = o; } }
    }
}

constexpr int KROW = 144;
constexpr int ATT_K = 0, ATT_V = 256 * KROW;
template <int MODE>
__device__ __forceinline__ void attn_unit(LAS unsigned char* lds, const bf16* Qb, long qstride, const bf16* Kb, const bf16* Vb, long kvstride, int first_key, float slope2,
                                          bf16* Ob, long ostride, float* lse, long lsestride, int tid, int lane, int wave) {
    __syncthreads();
    {   u32x4 kq[4], vq[4];
#pragma unroll
        for (int i = 0; i < 4; ++i) { const int id = tid + NTHR * i, key = id >> 3, c = id & 7;
            if (key >= first_key) { kq[i] = *(const u32x4*)(Kb + (long)key * kvstride + c * 8); vq[i] = *(const u32x4*)(Vb + (long)key * kvstride + c * 8); } }
#pragma unroll
        for (int i = 0; i < 4; ++i) { const int id = tid + NTHR * i, key = id >> 3, c = id & 7;
            if (key >= first_key) { *(LAS u32x4*)(lds + ATT_K + key * KROW + c * 16) = kq[i]; *(LAS u32x4*)(lds + ATT_V + key * KROW + c * 16) = vq[i]; } }
    }
    const int i16 = lane & 15, quad = lane >> 4, qi = 16 * wave + i16;
    const bf16* qp = Qb + (long)qi * qstride + 8 * quad;
    const bf16x8 Q0 = *(const bf16x8*)qp, Q1 = *(const bf16x8*)(qp + 32);
    __syncthreads();
    const int kt_lo = (MODE == 0) ? ((wave > (first_key >> 4)) ? wave : (first_key >> 4)) : 0, kt_hi = (MODE == 0) ? wave + 8 : 15;
    float m_run = -1e30f, l_run = 0.f; f32x4 O[4];
#pragma unroll
    for (int dt = 0; dt < 4; ++dt) O[dt] = (f32x4){0.f, 0.f, 0.f, 0.f};
    const float scale = 0.125f * LOG2E;
    const LAS unsigned char* kbase = lds + ATT_K + i16 * KROW + 16 * quad;
    const LAS unsigned char* vbase = lds + ATT_V + (4 * quad + (i16 >> 2)) * KROW + 8 * (i16 & 3);
    for (int kp = kt_lo; kp <= kt_hi; kp += 2) {
        const int ta = kp; const bool hasb = (kp + 1 <= kt_hi); const int tb = hasb ? kp + 1 : kp;
        const bf16x8 ka0 = *(const LAS bf16x8*)(kbase + ta * 16 * KROW), ka1 = *(const LAS bf16x8*)(kbase + ta * 16 * KROW + 64);
        const bf16x8 kb0 = *(const LAS bf16x8*)(kbase + tb * 16 * KROW), kb1 = *(const LAS bf16x8*)(kbase + tb * 16 * KROW + 64);
        f32x4 sa = (f32x4){0.f, 0.f, 0.f, 0.f}, sb = (f32x4){0.f, 0.f, 0.f, 0.f};
        sa = __builtin_amdgcn_mfma_f32_16x16x32_bf16(ka0, Q0, sa, 0, 0, 0); sa = __builtin_amdgcn_mfma_f32_16x16x32_bf16(ka1, Q1, sa, 0, 0, 0);
        sb = __builtin_amdgcn_mfma_f32_16x16x32_bf16(kb0, Q0, sb, 0, 0, 0); sb = __builtin_amdgcn_mfma_f32_16x16x32_bf16(kb1, Q1, sb, 0, 0, 0);
        float s[8];
#pragma unroll
        for (int r = 0; r < 4; ++r) {
            if (MODE == 0) {
                const int sta = qi + 128 - (16 * ta + 4 * quad + r), stb = qi + 128 - (16 * tb + 4 * quad + r);
                s[r] = ((unsigned)sta <= 128u) ? sa[r] * scale - slope2 * (float)sta : -1e30f;
                s[4 + r] = (hasb && (unsigned)stb <= 128u) ? sb[r] * scale - slope2 * (float)stb : -1e30f;
            } else { s[r] = sa[r] * scale; s[4 + r] = sb[r] * scale; }
        }
        float mx = fmaxf(fmaxf(fmaxf(s[0], s[1]), fmaxf(s[2], s[3])), fmaxf(fmaxf(s[4], s[5]), fmaxf(s[6], s[7])));
        mx = fmaxf(mx, __shfl_xor(mx, 16)); mx = fmaxf(mx, __shfl_xor(mx, 32));
        const float m_new = fmaxf(m_run, mx), al = __builtin_amdgcn_exp2f(m_run - m_new);
        float p[8], ps = 0.f;
#pragma unroll
        for (int r = 0; r < 8; ++r) { p[r] = __builtin_amdgcn_exp2f(s[r] - m_new); ps += p[r]; }
        l_run = l_run * al + ps; m_run = m_new;
        bf16x8 pf; { u32x4 w; w.x = pk2(p[0], p[1]); w.y = pk2(p[2], p[3]); w.z = pk2(p[4], p[5]); w.w = pk2(p[6], p[7]); pf = __builtin_bit_cast(bf16x8, w); }
#pragma unroll
        for (int dt = 0; dt < 4; ++dt) {
            const s16x4 va = tr_read(vbase + ta * 16 * KROW + dt * 32), vb = tr_read(vbase + tb * 16 * KROW + dt * 32);
            O[dt] = O[dt] * al;
            O[dt] = __builtin_amdgcn_mfma_f32_16x16x32_bf16(cat4(va, vb), pf, O[dt], 0, 0, 0);
        }
    }
    float lt = l_run; lt += __shfl_xor(lt, 16); lt += __shfl_xor(lt, 32);
    const float inv = 1.0f / lt;
    bf16* op = Ob + (long)qi * ostride + 4 * quad;
#pragma unroll
    for (int dt = 0; dt < 4; ++dt) { u32x2 o; o.x = pk2(O[dt][0] * inv, O[dt][1] * inv); o.y = pk2(O[dt][2] * inv, O[dt][3] * inv); *(u32x2*)(op + 16 * dt) = o; }
    if (MODE == 0 && quad == 0) lse[(long)qi * lsestride] = m_run + __builtin_amdgcn_logf(lt);
}

__device__ __forceinline__ void dil_unit(int u, const bf16* H, unsigned char* ws, LAS unsigned char* lds, int tid, int lane, int wave) {
    const int j = u & 15, p = (u >> 4) % 3, bh = u / 48, h = bh % 12, b = bh / 12;
    const int lg = 2 * p, dil = 1 << lg, r = j & (dil - 1), n = j >> lg;
    const float slope = __builtin_amdgcn_exp2f(-8.0f * (float)(h + 1) / 12.0f);
    const long tok0 = (long)b * SEQ + (long)n * 128 * dil + r;
    const long ktok0 = tok0 - (long)128 * dil;
    const bf16* Qb = H + tok0 * INA + h * 64;
    const bf16* Kb = H + ktok0 * INA + DILW + h * 64;
    const bf16* Vb = H + ktok0 * INA + 2 * DILW + h * 64;
    bf16* part = (p == 0) ? (bf16*)(ws + WS_XB) : (bf16*)(ws + WS_PART) + (size_t)(p - 1) * M * DILW;
    float* lse = (float*)(ws + WS_LSE) + (size_t)p * M * 12;
    attn_unit<0>(lds, Qb, (long)dil * INA, Kb, Vb, (long)dil * INA, n == 0 ? 128 : 0, slope * (float)dil * LOG2E,
                 part + tok0 * DILW + h * 64, (long)dil * DILW, lse + tok0 * 12 + h, (long)dil * 12, tid, lane, wave);
}
__device__ __forceinline__ void mem_unit(int u, const bf16* H, int ldh, int qoff, int layer, unsigned char* ws, LAS unsigned char* lds, int tid, int lane, int wave) {
    const int hm = u & 3, qb = (u >> 2) & 15, b = u >> 6;
    const long tok0 = (long)b * SEQ + qb * 128;
    const bf16* Kb = (const bf16*)(ws + WS_MKV) + (long)b * NMEM * 2048 + layer * 512 + hm * 64;
    attn_unit<1>(lds, H + tok0 * ldh + qoff + hm * 64, ldh, Kb, Kb + 256, 2048, 0, 0.f,
                 (bf16*)(ws + WS_MIX) + tok0 * D + DILW + hm * 64, D, nullptr, 0, tid, lane, wave);
}
__device__ __forceinline__ void merge_phase(unsigned char* ws, int tid) {
    const size_t gt = (size_t)blockIdx.x * NTHR + tid, NGT = (size_t)gridDim.x * NTHR;
    const bf16* P0 = (const bf16*)(ws + WS_XB); const bf16* P1 = (const bf16*)(ws + WS_PART); const bf16* P2 = P1 + (size_t)M * DILW;
    const float* L = (const float*)(ws + WS_LSE); bf16* MIX = (bf16*)(ws + WS_MIX);
    for (size_t i = gt; i < (size_t)M * 96; i += NGT) { const size_t tok = i / 96; const int c8 = (int)(i % 96), h = c8 >> 3;
        const float l0 = L[tok * 12 + h], l1 = L[(size_t)M * 12 + tok * 12 + h], l2 = L[(size_t)2 * M * 12 + tok * 12 + h];
        const float mx = fmaxf(l0, fmaxf(l1, l2)); float w0 = __builtin_amdgcn_exp2f(l0 - mx), w1 = __builtin_amdgcn_exp2f(l1 - mx), w2 = __builtin_amdgcn_exp2f(l2 - mx);
        const float inv = 1.0f / (w0 + w1 + w2); w0 *= inv; w1 *= inv; w2 *= inv;
        const u32x4 a = *(const u32x4*)(P0 + tok * DILW + c8 * 8), b = *(const u32x4*)(P1 + tok * DILW + c8 * 8), c = *(const u32x4*)(P2 + tok * DILW + c8 * 8);
        u32x4 o;
#pragma unroll
        for (int k = 0; k < 4; ++k) { const float lo = w0 * bflo(a[k]) + w1 * bflo(b[k]) + w2 * bflo(c[k]), hi = w0 * bfhi(a[k]) + w1 * bfhi(b[k]) + w2 * bfhi(c[k]); o[k] = pk2(lo, hi); }
        *(u32x4*)(MIX + tok * D + c8 * 8) = o; }
}

constexpr int SGU_STAT = 0, SGU_VN = 1024, SGU_VNB = 128 * KROW;
__device__ __forceinline__ void sgu_unit(int u, int jl, const float* sgu_g, const float* sgu_b, const float* sgu_bs, unsigned char* ws, const bf16* H, LAS unsigned char* lds, int tid, int lane, int wave) {
    typedef float f32x2v __attribute__((ext_vector_type(2)));
    const long t0 = (long)u * 128;
    LAS f32x2v* ST = (LAS f32x2v*)(lds + SGU_STAT);
    __syncthreads();
    for (int tt = 0; tt < 16; ++tt) { const int t = 16 * wave + tt; const bf16* row = H + (t0 + t) * INB + DILW;
        const u32x4 a = *(const u32x4*)(row + 8 * lane); u32x4 b = (u32x4){0u, 0u, 0u, 0u}; if (lane < 32) b = *(const u32x4*)(row + 512 + 8 * lane);
        float s = 0.f;
#pragma unroll
        for (int k = 0; k < 4; ++k) s += bflo(a[k]) + bfhi(a[k]) + bflo(b[k]) + bfhi(b[k]);
        const float mean = wave_sum(s) * (1.f / 768.f); float q = 0.f;
#pragma unroll
        for (int k = 0; k < 4; ++k) { const float d0 = bflo(a[k]) - mean, d1 = bfhi(a[k]) - mean; q += d0 * d0 + d1 * d1; if (lane < 32) { const float d2 = bflo(b[k]) - mean, d3 = bfhi(b[k]) - mean; q += d2 * d2 + d3 * d3; } }
        const float rstd = 1.f / sqrtf(wave_sum(q) * (1.f / 768.f) + LN_EPS);
        if (lane == 0) ST[t] = (f32x2v){mean, rstd};
    }
    __syncthreads();
    const int i16 = lane & 15, quad = lane >> 4, t = 16 * wave + i16, nks = (wave >> 1) + 1;
    const float* lng = sgu_g + jl * DILW; const float* lnb = sgu_b + jl * DILW;
    for (int g = 0; g < 12; ++g) {
        LAS unsigned char* vn = lds + SGU_VN + (g & 1) * SGU_VNB;
#pragma unroll
        for (int i = 0; i < 2; ++i) { const int id = tid + NTHR * i, s = id >> 3, c = id & 7; const f32x2v st = ST[s];
            const u32x4 a = *(const u32x4*)(H + (t0 + s) * INB + DILW + g * 64 + c * 8);
            const f32x4 g0 = *(const f32x4*)(lng + g * 64 + c * 8), g1 = *(const f32x4*)(lng + g * 64 + c * 8 + 4), b0 = *(const f32x4*)(lnb + g * 64 + c * 8), b1 = *(const f32x4*)(lnb + g * 64 + c * 8 + 4);
            u32x4 o;
            o.x = pk2((bflo(a.x) - st.x) * st.y * g0.x + b0.x, (bfhi(a.x) - st.x) * st.y * g0.y + b0.y); o.y = pk2((bflo(a.y) - st.x) * st.y * g0.z + b0.z, (bfhi(a.y) - st.x) * st.y * g0.w + b0.w);
            o.z = pk2((bflo(a.z) - st.x) * st.y * g1.x + b1.x, (bfhi(a.z) - st.x) * st.y * g1.y + b1.y); o.w = pk2((bflo(a.w) - st.x) * st.y * g1.z + b1.z, (bfhi(a.w) - st.x) * st.y * g1.w + b1.w);
            *(LAS u32x4*)(vn + s * KROW + c * 16) = o; }
        __syncthreads();
        f32x4 acc[4];
#pragma unroll
        for (int ct = 0; ct < 4; ++ct) acc[ct] = (f32x4){0.f, 0.f, 0.f, 0.f};
        const bf16* wrow = (const bf16*)(ws + WS_WS) + ((size_t)(jl * 12 + g) * 128 + t) * 128 + 8 * quad;
        const LAS unsigned char* vb = vn + (8 * quad + (i16 >> 2)) * KROW + 8 * (i16 & 3);
        for (int ks = 0; ks < nks; ++ks) { const bf16x8 wf = *(const bf16x8*)(wrow + 32 * ks);
#pragma unroll
            for (int ct = 0; ct < 4; ++ct) { const s16x4 v0 = tr_read(vb + ks * 32 * KROW + ct * 32), v1 = tr_read(vb + ks * 32 * KROW + 4 * KROW + ct * 32);
                acc[ct] = __builtin_amdgcn_mfma_f32_16x16x32_bf16(cat4(v0, v1), wf, acc[ct], 0, 0, 0); } }
        const float bs = sgu_bs[(size_t)(jl * 12 + g) * 128 + t];
        const bf16* up = H + (t0 + t) * INB + g * 64 + 4 * quad; bf16* op = (bf16*)(ws + WS_MIX) + (t0 + t) * D + g * 64 + 4 * quad;
#pragma unroll
        for (int ct = 0; ct < 4; ++ct) { const u32x2 uu = *(const u32x2*)(up + 16 * ct);
            u32x2 o; o.x = pk2(bflo(uu.x) * (acc[ct][0] + bs), bfhi(uu.x) * (acc[ct][1] + bs)); o.y = pk2(bflo(uu.y) * (acc[ct][2] + bs), bfhi(uu.y) * (acc[ct][3] + bs));
            *(u32x2*)(op + 16 * ct) = o; }
    }
}

#ifndef MK_SPLIT
#define MK_SPLIT 0
#endif
__global__ void __launch_bounds__(NTHR, 2) fwd_kernel(Ptrs Pdummy, int ph_lo_, int ph_hi_) {
    extern __shared__ __attribute__((aligned(16))) unsigned char lds_raw[];
    LAS unsigned char* lds = (LAS unsigned char*)lds_raw;
    const kargp_t kp = (kargp_t)__builtin_amdgcn_kernarg_segment_ptr();
    int phase = 0;
#if MK_SPLIT
    const int ph_lo = ph_lo_, ph_hi = ph_hi_;
#define SEAM() do { ++phase; } while (0)
#define RUN (phase >= ph_lo && phase < ph_hi)
#else
    cg::grid_group grid = cg::this_grid();
#define SEAM() do { grid.sync(); } while (0)
#define RUN true
#endif
#define WSP(off) (KP(ws) + (off))
    if (RUN) { TIDS(); prologue(kp, lds, tid, lane, wave); }
    SEAM();
    if (RUN) {
        unsigned char* ws = KP(ws);
        pg8::Gemm g{(const bf16*)(ws + WS_MEMB), (const bf16*)(ws + WS_WMKV), MMEM, 2048, D}; pg8::StaticOrder S; S.init(MMEM, 2048, (int)gridDim.x, (int)blockIdx.x);
        pg8::EpiStore E{(bf16*)(ws + WS_MKV), 2048, 0};
        pg8::gemm_phase<pg8::EpiStore, pg8::StaticOrder, true, true>(lds, g, S, E);
    }
#pragma unroll 1
    for (int layer = 0; layer < DEPTH; ++layer) {
        const int jl = layer >> 1; const bool isA = (layer & 1) == 0;
        if (RUN) {
            unsigned char* ws = KP(ws); const int ldh = isA ? INA : INB;
            pg8::Gemm g{(const bf16*)(ws + WS_XB), isA ? (const bf16*)(ws + WS_WINA) + (size_t)jl * INA * D : (const bf16*)(ws + WS_WINB) + (size_t)jl * INB * D, M, ldh, D};
            pg8::StaticOrder S; S.init(M, ldh, (int)gridDim.x, (int)blockIdx.x);
            pg8::EpiStore E{(bf16*)(ws + WS_H), ldh, isA ? 0 : 6};
            pg8::gemm_phase<pg8::EpiStore, pg8::StaticOrder, true, true>(lds, g, S, E);
        }
        SEAM();
        if (isA) {
            if (RUN) {
                unsigned char* ws = KP(ws); const bf16* H = (const bf16*)(ws + WS_H);
                for (int u = blockIdx.x; u < 18432 + 2048; u += gridDim.x) { TIDS();
                    if (u < 18432) dil_unit(u, H, ws, lds, tid, lane, wave); else mem_unit(u - 18432, H, INA, 3 * DILW, layer, ws, lds, tid, lane, wave);
                }
            }
            SEAM();
            if (RUN) { TIDS(); (void)lane; (void)wave; merge_phase(KP(ws), tid); }
        } else {
            if (RUN) {
                unsigned char* ws = KP(ws); const bf16* H = (const bf16*)(ws + WS_H);
                const float* sg = KP(sgu_g); const float* sb = KP(sgu_b); const float* sbs = KP(sgu_bs);
                for (int u = blockIdx.x; u < 512 + 2048; u += gridDim.x) { TIDS();
                    if (u < 512) sgu_unit(u, jl, sg, sb, sbs, ws, H, lds, tid, lane, wave); else mem_unit(u - 512, H, INB, 2 * DILW, layer, ws, lds, tid, lane, wave);
                }
            }
        }
        SEAM();
        if (RUN) {
            __syncthreads();
            unsigned char* ws = KP(ws); float* out = KP(out); const float* base = (layer == 0) ? KP(x) : (const float*)out;
            pg8::Gemm g{(const bf16*)(ws + WS_MIX), (const bf16*)(ws + WS_WOUT) + (size_t)layer * D * D, M, D, D}; pg8::StaticOrder S; S.init(M, D, (int)gridDim.x, (int)blockIdx.x);
            pg8::EpiResid E{base, out, D, DN_ALPHA};
            pg8::gemm_phase<pg8::EpiResid, pg8::StaticOrder, true, true>(lds, g, S, E);
        }
        SEAM();
        if (RUN) { TIDS(); (void)tid; ln_phase(KP(out), KP(ln1g) + layer * D, KP(ln1b) + layer * D, (bf16*)WSP(WS_XB), lane, wave); }
        SEAM();
        if (RUN) {
            unsigned char* ws = KP(ws);
            pg8::Gemm g{(const bf16*)(ws + WS_XB), (const bf16*)(ws + WS_WFF) + (size_t)layer * FF2 * D, M, FF2, D}; pg8::StaticOrder S; S.init(M, FF2, (int)gridDim.x, (int)blockIdx.x);
            pg8::EpiSwiGLU E{(bf16*)(ws + WS_H), FF};
            pg8::gemm_phase<pg8::EpiSwiGLU, pg8::StaticOrder, true, true>(lds, g, S, E);
        }
        SEAM();
        if (RUN) {
            unsigned char* ws = KP(ws); float* out = KP(out);
            pg8::Gemm g{(const bf16*)(ws + WS_H), (const bf16*)(ws + WS_WDN) + (size_t)layer * D * FF, M, D, FF}; pg8::StaticOrder S; S.init(M, D, (int)gridDim.x, (int)blockIdx.x);
            pg8::EpiResid E{out, out, D, DN_ALPHA};
            pg8::gemm_phase<pg8::EpiResid, pg8::StaticOrder, true, true>(lds, g, S, E);
        }
        SEAM();
        if (RUN) { TIDS(); (void)tid; ln_phase(KP(out), KP(ln2g) + layer * D, KP(ln2b) + layer * D, layer + 1 < DEPTH ? (bf16*)WSP(WS_XB) : nullptr, lane, wave); }
        if (layer + 1 < DEPTH) SEAM();
    }
}

extern "C" void kernel_launch(void* const* d_in, const int* in_sizes, int n_in, void* d_out, int out_size, void* d_ws, size_t ws_size, hipStream_t stream) {
    static int grid = 0;
    if (grid == 0) {
        if (n_in != 17 || out_size != M * D || ws_size < WS_END) { fprintf(stderr, "kernel_launch: unexpected shapes (n_in %d out %d ws %zu)\n", n_in, out_size, ws_size); grid = -1; return; }
        int dev = 0, cus = 0, per_cu = 0;
        hipGetDevice(&dev); hipDeviceGetAttribute(&cus, hipDeviceAttributeMultiprocessorCount, dev);
        if (hipFuncSetAttribute((const void*)fwd_kernel, hipFuncAttributeMaxDynamicSharedMemorySize, LDS_BYTES) != hipSuccess) { fprintf(stderr, "kernel_launch: hipFuncSetAttribute failed\n"); grid = -1; return; }
        hipOccupancyMaxActiveBlocksPerMultiprocessor(&per_cu, (const void*)fwd_kernel, NTHR, LDS_BYTES);
        (void)hipGetLastError();
        if (per_cu < 1) per_cu = 1;
        grid = cus * per_cu;
        fprintf(stderr, "kernel_launch: grid %d (cus %d x %d)\n", grid, cus, per_cu);
    }
    if (grid < 0) return;
    Ptrs p{};
    p.x = (const float*)d_in[0]; p.mem = (const float*)d_in[1]; p.a_w_in = (const float*)d_in[2]; p.b_w_in = (const float*)d_in[3];
    p.sgu_g = (const float*)d_in[4]; p.sgu_b = (const float*)d_in[5]; p.sgu_ws = (const float*)d_in[6]; p.sgu_bs = (const float*)d_in[7];
    p.w_mkv = (const float*)d_in[8]; p.w_out = (const float*)d_in[9]; p.ln1g = (const float*)d_in[10]; p.ln1b = (const float*)d_in[11];
    p.w_gate = (const float*)d_in[12]; p.w_up = (const float*)d_in[13]; p.w_down = (const float*)d_in[14]; p.ln2g = (const float*)d_in[15]; p.ln2b = (const float*)d_in[16];
    p.out = (float*)d_out; p.ws = (unsigned char*)d_ws;
#if MK_SPLIT
    for (int ph = 0; ph < 64; ++ph) { int lo = ph, hi = ph + 1; hipLaunchKernelGGL(fwd_kernel, dim3(grid), dim3(NTHR), LDS_BYTES, stream, p, lo, hi); }
#else
    int lo = 0, hi = 1 << 30;
    void* args[] = {&p, &lo, &hi};
    hipError_t e = hipLaunchCooperativeKernel((const void*)fwd_kernel, dim3(grid), dim3(NTHR), args, LDS_BYTES, stream);
    if (e != hipSuccess) fprintf(stderr, "cooperative launch failed: %s (grid %d)\n", hipGetErrorString(e), grid);
#endif
}
```

```cpp
#include <hip/hip_runtime.h>
#include <cstdio>
#include <cstdint>
namespace pg8 {
#define PG8_LAS __attribute__((address_space(3)))
typedef unsigned short bf16_t;
typedef short bf16x8 __attribute__((ext_vector_type(8)));
typedef float f32x4 __attribute__((ext_vector_type(4)));
typedef unsigned u32x4 __attribute__((ext_vector_type(4)));
constexpr int BM = 256, BK = 64, HALF = 128, HTB = HALF * BK * 2  , STAGE_BYTES = 8 * HTB, NXCD = 8, WGM = 8;

__host__ __device__ __forceinline__ int lds_byte(int r, int c) { const int st = (r >> 4) * 2 + (c >> 5), rr = r & 15, cc = c & 31, ob = rr * 64 + cc * 2; return st * 1024 + (ob ^ (((ob >> 9) & 1) << 5)); }
__host__ __device__ __forceinline__ void stage_rc(int b, int& R, int& C) { const int st = b / 1024, sb = b % 1024, swz = sb ^ (((sb >> 9) & 1) << 5); R = (st >> 1) * 16 + swz / 64; C = (st & 1) * 32 + (swz % 64) / 2; }
__host__ __device__ __forceinline__ int perm32(int rho) { const int n = rho >> 4, i = rho & 15; return 8 * (i >> 2) + 4 * n + (i & 3); }

struct Unit { int pm, pn; };
struct Gemm { const bf16_t* A; const bf16_t* Bt; int M, N, K; };

struct StaticOrder {
    int nM, nN, nwg, G, c;
    __host__ __device__ void init(int M, int N, int G_, int c_) { nM = M / BM; nN = N / BM; nwg = nM * nN; G = G_; c = c_; }
    __host__ __device__ bool next(int i, Unit& u) const {
        const long L = (long)i * G + c; if (L >= nwg) return false;
        int wgid = (int)L; { const int q = nwg / NXCD, r = nwg % NXCD, xcd = wgid % NXCD, off = wgid / NXCD; wgid = (xcd < r ? xcd * (q + 1) : r * (q + 1) + (xcd - r) * q) + off; }
        const int nig = WGM * nN, gid = wgid / nig, fm = gid * WGM, gsz = (nM - fm) < WGM ? (nM - fm) : WGM;
        u.pm = fm + ((wgid % nig) % gsz); u.pn = (wgid % nig) / gsz; return true;
    }
    __device__ __forceinline__ void a_ready(const Unit&) const {}
    __device__ __forceinline__ void done(const Unit&) const {}
};

__device__ __forceinline__ unsigned cvt_pk_bf16(float lo, float hi) { unsigned r; asm volatile("v_cvt_pk_bf16_f32 %0, %1, %2" : "=v"(r) : "v"(lo), "v"(hi)); return r; }
typedef float f32x2 __attribute__((ext_vector_type(2)));
__device__ __forceinline__ float sigm_fast(float z) { return __builtin_amdgcn_rcpf(1.0f + __builtin_amdgcn_exp2f(-1.4426950408889634f * z)); }
__device__ __forceinline__ float gelu_tanh(float x) { const float z = 1.5957691216057308f * (x + 0.044715f * x * x * x); return x * sigm_fast(z); }
__device__ __forceinline__ float silu_f(float x) { return x * sigm_fast(x); }
struct EpiStore {
    static constexpr bool PERM = true, AFTER_DRAIN = false;
    bf16_t* O; int ldc; int gelu_tiles;
    __device__ __forceinline__ void operator()(const f32x4 (&acc)[2][2][4][2], const Unit& u, int wr, int wc, int fr, int fq) const {
        const int row0 = u.pm * BM + wr * 64 + fr, col0 = u.pn * BM + wc * 32 + 8 * fq; const bool g = u.pn < gelu_tiles;
#pragma unroll
        for (int ai = 0; ai < 2; ++ai)
#pragma unroll
            for (int m = 0; m < 4; ++m) { bf16_t* rowp = O + (size_t)(row0 + ai * HALF + m * 16) * ldc + col0;
#pragma unroll
                for (int bj = 0; bj < 2; ++bj) { f32x4 v0 = acc[ai][bj][m][0], v1 = acc[ai][bj][m][1];
                    if (g) {
#pragma unroll
                        for (int e = 0; e < 4; ++e) { v0[e] = gelu_tanh(v0[e]); v1[e] = gelu_tanh(v1[e]); } }
                    u32x4 w; w.x = cvt_pk_bf16(v0[0], v0[1]); w.y = cvt_pk_bf16(v0[2], v0[3]); w.z = cvt_pk_bf16(v1[0], v1[1]); w.w = cvt_pk_bf16(v1[2], v1[3]);
                    *(u32x4*)(rowp + bj * HALF) = w; } }
    }
};
struct EpiSwiGLU {
    static constexpr bool PERM = true, AFTER_DRAIN = false;
    bf16_t* O; int ldc;
    __device__ __forceinline__ void operator()(const f32x4 (&acc)[2][2][4][2], const Unit& u, int wr, int wc, int fr, int fq) const {
        const int row0 = u.pm * BM + wr * 64 + fr, col0 = u.pn * HALF + wc * 32 + 8 * fq;
#pragma unroll
        for (int ai = 0; ai < 2; ++ai)
#pragma unroll
            for (int m = 0; m < 4; ++m) { bf16_t* rowp = O + (size_t)(row0 + ai * HALF + m * 16) * ldc + col0;
                f32x4 h0, h1;
#pragma unroll
                for (int e = 0; e < 4; ++e) { h0[e] = silu_f(acc[ai][0][m][0][e]) * acc[ai][1][m][0][e]; h1[e] = silu_f(acc[ai][0][m][1][e]) * acc[ai][1][m][1][e]; }
                u32x4 w; w.x = cvt_pk_bf16(h0[0], h0[1]); w.y = cvt_pk_bf16(h0[2], h0[3]); w.z = cvt_pk_bf16(h1[0], h1[1]); w.w = cvt_pk_bf16(h1[2], h1[3]);
                *(u32x4*)rowp = w; }
    }
};
struct EpiResid {
    static constexpr bool PERM = true, AFTER_DRAIN = false;
    const float* base; float* out; int ldc; float alpha;
    __device__ __forceinline__ void operator()(const f32x4 (&acc)[2][2][4][2], const Unit& u, int wr, int wc, int fr, int fq) const {
        const int row0 = u.pm * BM + wr * 64 + fr, col0 = u.pn * BM + wc * 32 + 8 * fq;
#pragma unroll
        for (int ai = 0; ai < 2; ++ai)
#pragma unroll
            for (int m = 0; m < 4; ++m) { const size_t off = (size_t)(row0 + ai * HALF + m * 16) * ldc + col0;
#pragma unroll
                for (int bj = 0; bj < 2; ++bj) { const f32x4 b0 = *(const f32x4*)(base + off + bj * HALF), b1 = *(const f32x4*)(base + off + bj * HALF + 4);
                    *(f32x4*)(out + off + bj * HALF) = b0 * alpha + acc[ai][bj][m][0]; *(f32x4*)(out + off + bj * HALF + 4) = b1 * alpha + acc[ai][bj][m][1]; } }
    }
};
template <class Epi, class Sched, bool ALIGN_EPI = false, bool SP2 = false>
__device__ __forceinline__ void gemm_phase(PG8_LAS unsigned char* lds, const Gemm g, const Sched& S, const Epi& E) {
    int tid_ = threadIdx.x; asm volatile("" : "+v"(tid_)); const int tid = tid_, wid = __builtin_amdgcn_readfirstlane(tid >> 6), lane = tid & 63, wr = wid >> 2, wc = wid & 3, fr = lane & 15, fq = lane >> 4;
    const int K = g.K, nt = K / BK;
    unsigned voffA[2], voffB[2];
#pragma unroll
    for (int i = 0; i < 2; ++i) { int R, C; stage_rc(tid * 16 + i * 8192, R, C); const int Rb = Epi::PERM ? ((R & ~31) + perm32(R & 31)) : R;
        voffA[i] = (unsigned)(R * K + C) * 2u; voffB[i] = (unsigned)(Rb * K + C) * 2u; }
    const size_t kstep = (size_t)(BK * 2);
    const size_t hstep = (size_t)HALF * K * 2;
    const size_t tstep = 2 * hstep;
    const unsigned ldsw = (unsigned)wid * 1024u;
    const int aoff = lds_byte(wr * 64 + fr, fq * 8), boff = lds_byte(wc * 32 + fr, fq * 8);
#define PG8_SA(b, h) (((b) * 2 + (h)) * HTB)
#define PG8_SB(b, h) ((4 + (b) * 2 + (h)) * HTB)
#define PG8_STAGE(bufoff, gbase, voff) do { _Pragma("unroll") for (int _i = 0; _i < 2; ++_i) \
        __builtin_amdgcn_global_load_lds((const unsigned*)((const char*)(gbase) + (voff)[_i]), (PG8_LAS unsigned*)(lds + (bufoff) + ldsw + _i * 8192), 16, 0, 0); } while (0)
#define PG8_LDA(dst, b, h) do { _Pragma("unroll") for (int m = 0; m < 4; ++m) _Pragma("unroll") for (int k = 0; k < 2; ++k) dst[m][k] = *(const PG8_LAS bf16x8*)(lds + PG8_SA(b, h) + aoff + m * 2048 + k * 1024); } while (0)
#define PG8_LDB(dst, b, h) do { _Pragma("unroll") for (int n = 0; n < 2; ++n) _Pragma("unroll") for (int k = 0; k < 2; ++k) dst[n][k] = *(const PG8_LAS bf16x8*)(lds + PG8_SB(b, h) + boff + n * 2048 + k * 1024); } while (0)
#define PG8_MMA(ai, bj, At, Bt) do { __builtin_amdgcn_s_setprio(1); _Pragma("unroll") for (int m = 0; m < 4; ++m) _Pragma("unroll") for (int n = 0; n < 2; ++n) _Pragma("unroll") for (int k = 0; k < 2; ++k) \
        acc[ai][bj][m][n] = __builtin_amdgcn_mfma_f32_16x16x32_bf16(Bt[n][k], At[m][k], acc[ai][bj][m][n], 0, 0, 0); __builtin_amdgcn_s_setprio(0); } while (0)
#define PG8_WAIT_V(n) asm volatile("s_waitcnt vmcnt(" #n ")" ::: "memory")
#define PG8_WAIT_L(n) asm volatile("s_waitcnt lgkmcnt(" #n ")" ::: "memory")
#define PG8_BAR __builtin_amdgcn_s_barrier()
#define PG8_SCHED __builtin_amdgcn_sched_barrier(0)
    Unit cur, nxt; int ui = 0;
    if (!S.next(0, cur)) return;
    f32x4 acc[2][2][4][2];
#pragma unroll
    for (int a = 0; a < 2; ++a)
#pragma unroll
        for (int b = 0; b < 2; ++b)
#pragma unroll
            for (int m = 0; m < 4; ++m)
#pragma unroll
                for (int n = 0; n < 2; ++n) acc[a][b][m][n] = (f32x4){0.f, 0.f, 0.f, 0.f};
    bf16x8 At[4][2], B0[2][2], B1[2][2];
    const char* cA = (const char*)g.A + (size_t)cur.pm * tstep; const char* cB = (const char*)g.Bt + (size_t)cur.pn * tstep;
    S.a_ready(cur);
    if constexpr (SP2) {
        PG8_STAGE(PG8_SB(0, 0), cB, voffB); PG8_STAGE(PG8_SB(0, 1), cB + hstep, voffB); PG8_STAGE(PG8_SA(0, 0), cA, voffA); PG8_STAGE(PG8_SA(0, 1), cA + hstep, voffA);
        if (wr == 1) PG8_BAR;
        PG8_WAIT_V(2); PG8_BAR;
        PG8_STAGE(PG8_SB(1, 0), cB + kstep, voffB); PG8_STAGE(PG8_SA(1, 0), cA + kstep, voffA); PG8_STAGE(PG8_SB(1, 1), cB + hstep + kstep, voffB);
        PG8_WAIT_V(6); PG8_BAR;
    } else {
        PG8_STAGE(PG8_SB(0, 0), cB, voffB); PG8_STAGE(PG8_SA(0, 0), cA, voffA); PG8_STAGE(PG8_SB(0, 1), cB + hstep, voffB); PG8_STAGE(PG8_SA(0, 1), cA + hstep, voffA);
        if (wr == 1) PG8_BAR;
        PG8_WAIT_V(4); PG8_BAR;
        PG8_STAGE(PG8_SB(1, 0), cB + kstep, voffB); PG8_STAGE(PG8_SA(1, 0), cA + kstep, voffA); PG8_STAGE(PG8_SB(1, 1), cB + hstep + kstep, voffB);
        PG8_WAIT_V(6); PG8_BAR;
    }
    for (;;) {
        const bool has_next = S.next(ui + 1, nxt);
        const char* nA = has_next ? (const char*)g.A + (size_t)nxt.pm * tstep : cA; const char* nB = has_next ? (const char*)g.Bt + (size_t)nxt.pn * tstep : cB;
        for (int t = 0; t < nt; t += 2) {
            const bool last = (t == nt - 2);
            const char* a1 = cA + (size_t)(t + 1) * kstep;
            const char* a2 = last ? nA : cA + (size_t)(t + 2) * kstep; const char* b2 = last ? nB : cB + (size_t)(t + 2) * kstep;
            const char* a3 = a2 + kstep; const char* b3 = b2 + kstep;
            if (last && has_next) S.a_ready(nxt);
            if constexpr (SP2) {
            PG8_LDB(B0, 0, 0); PG8_LDB(B1, 0, 1); PG8_SCHED; PG8_LDA(At, 0, 0); PG8_STAGE(PG8_SA(1, 1), a1 + hstep, voffA);
            PG8_WAIT_V(8); PG8_WAIT_L(0); PG8_BAR; PG8_MMA(0, 0, At, B0); PG8_MMA(0, 1, At, B1); PG8_BAR; PG8_SCHED;
            PG8_LDA(At, 0, 1); PG8_STAGE(PG8_SB(0, 0), b2, voffB); PG8_STAGE(PG8_SB(0, 1), b2 + hstep, voffB); PG8_STAGE(PG8_SA(0, 0), a2, voffA);
            PG8_WAIT_V(8); PG8_WAIT_L(0); PG8_BAR; PG8_MMA(1, 0, At, B0); PG8_MMA(1, 1, At, B1); PG8_BAR; PG8_SCHED;
            PG8_LDB(B0, 1, 0); PG8_LDB(B1, 1, 1); PG8_SCHED; PG8_LDA(At, 1, 0); PG8_STAGE(PG8_SA(0, 1), a2 + hstep, voffA);
            PG8_WAIT_V(8); PG8_WAIT_L(0); PG8_BAR; PG8_MMA(0, 0, At, B0); PG8_MMA(0, 1, At, B1); PG8_BAR; PG8_SCHED;
            PG8_LDA(At, 1, 1); PG8_STAGE(PG8_SB(1, 0), b3, voffB); PG8_STAGE(PG8_SB(1, 1), b3 + hstep, voffB); PG8_STAGE(PG8_SA(1, 0), a3, voffA);
            PG8_WAIT_V(8); PG8_WAIT_L(0); PG8_BAR; PG8_MMA(1, 0, At, B0); PG8_MMA(1, 1, At, B1); PG8_BAR; PG8_SCHED;
            } else {
            PG8_LDB(B0, 0, 0); PG8_SCHED; PG8_LDA(At, 0, 0); PG8_STAGE(PG8_SA(1, 1), a1 + hstep, voffA);
            PG8_WAIT_L(8); PG8_BAR; PG8_WAIT_L(0); PG8_MMA(0, 0, At, B0); PG8_BAR; PG8_SCHED;
            PG8_LDB(B1, 0, 1); PG8_STAGE(PG8_SB(0, 0), b2, voffB);
            PG8_BAR; PG8_WAIT_L(0); PG8_MMA(0, 1, At, B1); PG8_BAR;
            PG8_LDA(At, 0, 1); PG8_STAGE(PG8_SA(0, 0), a2, voffA);
            PG8_BAR; PG8_WAIT_L(0); PG8_MMA(1, 0, At, B0); PG8_BAR; PG8_SCHED;
            PG8_STAGE(PG8_SB(0, 1), b2 + hstep, voffB);
            PG8_WAIT_V(6); PG8_BAR; PG8_MMA(1, 1, At, B1); PG8_BAR;
            PG8_LDB(B0, 1, 0); PG8_SCHED; PG8_LDA(At, 1, 0); PG8_STAGE(PG8_SA(0, 1), a2 + hstep, voffA);
            PG8_WAIT_L(8); PG8_BAR; PG8_WAIT_L(0); PG8_MMA(0, 0, At, B0); PG8_BAR; PG8_SCHED;
            PG8_LDB(B1, 1, 1); PG8_STAGE(PG8_SB(1, 0), b3, voffB);
            PG8_BAR; PG8_WAIT_L(0); PG8_MMA(0, 1, At, B1); PG8_BAR;
            PG8_LDA(At, 1, 1); PG8_STAGE(PG8_SA(1, 0), a3, voffA);
            PG8_BAR; PG8_WAIT_L(0); PG8_MMA(1, 0, At, B0); PG8_BAR; PG8_SCHED;
            PG8_STAGE(PG8_SB(1, 1), b3 + hstep, voffB);
            PG8_WAIT_V(6); PG8_BAR; PG8_MMA(1, 1, At, B1); PG8_BAR;
            }
        }
        if constexpr (ALIGN_EPI) { if (wr == 0) PG8_BAR; }
        if constexpr (!Epi::AFTER_DRAIN) { E(acc, cur, wr, wc, fr, fq); S.done(cur); }
        if (!has_next) break;
#pragma unroll
        for (int a = 0; a < 2; ++a)
#pragma unroll
            for (int b = 0; b < 2; ++b)
#pragma unroll
                for (int m = 0; m < 4; ++m)
#pragma unroll
                    for (int n = 0; n < 2; ++n) acc[a][b][m][n] = (f32x4){0.f, 0.f, 0.f, 0.f};
        cur = nxt; cA = nA; cB = nB; ++ui;
        if constexpr (ALIGN_EPI) { if (wr == 1) PG8_BAR; }
    }
    PG8_WAIT_V(0);
    if constexpr (!ALIGN_EPI) { if (wr == 0) PG8_BAR; }
    PG8_BAR;
    if constexpr (Epi::AFTER_DRAIN) { E.fused(acc, cur, wr, wc, fr, fq, lds, wid, lane); S.done(cur); }
#undef PG8_SA
#undef PG8_SB
#undef PG8_STAGE
#undef PG8_LDA
#undef PG8_LDB
#undef PG8_MMA
#undef PG8_WAIT_V
#undef PG8_WAIT_L
#undef PG8_BAR
#undef PG8_SCHED
}
}
#include <hip/hip_cooperative_groups.h>
namespace cg = cooperative_groups;
#define LAS __attribute__((address_space(3)))
typedef unsigned short bf16;
typedef float f32x4 __attribute__((ext_vector_type(4)));
typedef short bf16x8 __attribute__((ext_vector_type(8)));
typedef short s16x4 __attribute__((ext_vector_type(4)));
typedef unsigned u32x4 __attribute__((ext_vector_type(4)));
typedef unsigned u32x2 __attribute__((ext_vector_type(2)));
typedef short v4i16_t __attribute__((ext_vector_type(4)));

constexpr int NWAVES = 8, NTHR = 512;
constexpr int BATCH = 32, SEQ = 2048, D = 1024, M = BATCH * SEQ, NMEM = 256, MMEM = BATCH * NMEM;
constexpr int INA = 2560, INB = 1792, FF = 2816, FF2 = 5632, DEPTH = 4, DILW = 768;
constexpr float LN_EPS = 1e-5f, DN_ALPHA = 1.6817928305074290f  , LOG2E = 1.4426950408889634f;
constexpr size_t MiB = 1u << 20;
constexpr size_t WS_WINA = 1 * MiB;
constexpr size_t WS_WINB = WS_WINA + 10 * MiB;
constexpr size_t WS_WMKV = WS_WINB + 7 * MiB;
constexpr size_t WS_WOUT = WS_WMKV + 4 * MiB;
constexpr size_t WS_WFF = WS_WOUT + 8 * MiB;
constexpr size_t WS_WDN = WS_WFF + 44 * MiB;
constexpr size_t WS_WS = WS_WDN + 22 * MiB;
constexpr size_t WS_MEMB = WS_WS + 1 * MiB;
constexpr size_t WS_MKV = WS_MEMB + 16 * MiB;
constexpr size_t WS_XB = WS_MKV + 32 * MiB;
constexpr size_t WS_H = WS_XB + 128 * MiB;
constexpr size_t WS_MIX = WS_H + 320 * MiB;
constexpr size_t WS_PART = WS_MIX + 128 * MiB;
constexpr size_t WS_LSE = WS_PART + 192 * MiB;
constexpr size_t WS_END = WS_LSE + 9 * MiB;
static_assert(WS_H + (size_t)M * FF * 2 <= WS_PART, "HID overlay");
static_assert(WS_END <= 1024 * MiB, "ws");
constexpr int LDS_BYTES = 147456;

__device__ __forceinline__ unsigned f2bf(float f) { unsigned u = __builtin_bit_cast(unsigned, f); return (u + 0x7fffu + ((u >> 16) & 1u)) >> 16; }
__device__ __forceinline__ unsigned pk2(float lo, float hi) { return pg8::cvt_pk_bf16(lo, hi); }
__device__ __forceinline__ float bflo(unsigned w) { return __builtin_bit_cast(float, w << 16); }
__device__ __forceinline__ float bfhi(unsigned w) { return __builtin_bit_cast(float, w & 0xffff0000u); }
__device__ __forceinline__ int otid() { int t = threadIdx.x; asm volatile("" : "+v"(t)); return t; }
#define TIDS() const int tid = otid(), lane = tid & 63, wave = __builtin_amdgcn_readfirstlane(tid >> 6)
__device__ __forceinline__ float wave_sum(float v) {
#pragma unroll
    for (int o = 1; o < 64; o <<= 1) v += __shfl_xor(v, o);
    return v;
}
__device__ __forceinline__ s16x4 tr_read(const LAS unsigned char* p) { return __builtin_bit_cast(s16x4, __builtin_amdgcn_ds_read_tr16_b64_v4i16((LAS v4i16_t*)p)); }
__device__ __forceinline__ bf16x8 cat4(s16x4 a, s16x4 b) { bf16x8 r; r[0] = a[0]; r[1] = a[1]; r[2] = a[2]; r[3] = a[3]; r[4] = b[0]; r[5] = b[1]; r[6] = b[2]; r[7] = b[3]; return r; }

#define XB_TMO      128
#define XB_XCNT(j)  (256  + 64 * (j))
#define XB_XSUB(j)  (1280 + 64 * (j))
#define XB_XGEN(j)  (2304 + 64 * (j))
#define XB_TOP      3328
#define XB_TOPGEN   3392
#define XCD_BAR_WORDS 3456
#define XB_SPIN_CAP (1u << 18)

__device__ __forceinline__ unsigned xb_ld(unsigned* p)              { return __hip_atomic_load(p, __ATOMIC_RELAXED, __HIP_MEMORY_SCOPE_AGENT); }
__device__ __forceinline__ unsigned xb_add(unsigned* p, unsigned v) { return __hip_atomic_fetch_add(p, v, __ATOMIC_RELAXED, __HIP_MEMORY_SCOPE_AGENT); }
__device__ __forceinline__ unsigned xb_xcc_id() { return (unsigned)__builtin_amdgcn_s_getreg((3 << 11) | 20) & 0xFu; }
#define XB_SPIN(cond, bar) do { unsigned _sp = 0; while (cond) { __builtin_amdgcn_s_sleep(1); \
    if ((++_sp & 255u) == 0u) { if (xb_ld(&(bar)[XB_TMO])) break; if (_sp > XB_SPIN_CAP) { atomicAdd(&(bar)[XB_TMO], 1u); break; } } } } while (0)

struct XcdBarrier {
    unsigned* bar; unsigned x;
    volatile LAS unsigned* st;
};

__device__ __forceinline__ XcdBarrier xcd_barrier_post(unsigned* bar, volatile LAS unsigned* st) {
    XcdBarrier b; b.bar = bar; b.x = xb_xcc_id(); b.st = st;
    if (threadIdx.x == 0) (void)xb_add(&bar[XB_XCNT(b.x)], 1u);
    return b;
}
__device__ __forceinline__ void xcd_barrier_complete(unsigned* bar, unsigned x, unsigned& nloc, unsigned& nx) {
    const unsigned G = gridDim.x * gridDim.y * gridDim.z;
    unsigned sum, cnt, mine, sp = 0u;
    for (;;) {
        sum = 0u; cnt = 0u; mine = 0u;
#pragma unroll
        for (unsigned j = 0; j < 16; ++j) { const unsigned c = xb_ld(&bar[XB_XCNT(j)]); sum += c; cnt += (c > 0u) ? 1u : 0u; mine = (j == x) ? c : mine; }
        if (sum == G) break;
        __builtin_amdgcn_s_sleep(1);
        if ((++sp & 255u) == 0u) { if (xb_ld(&bar[XB_TMO])) break; if (sp > XB_SPIN_CAP) { atomicAdd(&bar[XB_TMO], 1u); break; } }
    }
    nloc = mine > 0u ? mine : 1u; nx = cnt > 0u ? cnt : 1u;
}

__device__ __forceinline__ void xcd_barrier(const XcdBarrier& b) {
    asm volatile("s_waitcnt vmcnt(0)" ::: "memory");
    __syncthreads();
    if (threadIdx.x == 0) {
        unsigned* bar = b.bar;
        __builtin_amdgcn_s_waitcnt(0);
        unsigned nloc = b.st[0], nx = b.st[1];
        if (nloc == 0u) { xcd_barrier_complete(bar, b.x, nloc, nx); b.st[0] = nloc; b.st[1] = nx; }
        const unsigned old = xb_add(&bar[XB_XSUB(b.x)], 1u);
        const unsigned gen = old / nloc;
        if (old + 1u == (gen + 1u) * nloc) {
            __builtin_amdgcn_fence(__ATOMIC_RELEASE, "agent");
            asm volatile("s_waitcnt vmcnt(0)" ::: "memory");
            const unsigned og = xb_add(&bar[XB_TOP], 1u);
            const unsigned tg = og / nx;
            if (og + 1u == (tg + 1u) * nx) xb_add(&bar[XB_TOPGEN], 1u);
            else XB_SPIN(xb_ld(&bar[XB_TOPGEN]) == tg, bar);
            __builtin_amdgcn_fence(__ATOMIC_ACQUIRE, "agent");
            xb_add(&bar[XB_XGEN(b.x)], 1u);
            asm volatile("s_waitcnt vmcnt(0)" ::: "memory");
        } else {
            XB_SPIN(xb_ld(&bar[XB_XGEN(b.x)]) == gen, bar);
            __builtin_amdgcn_fence(__ATOMIC_ACQUIRE, "agent");
            asm volatile("s_waitcnt vmcnt(0)" ::: "memory");
        }
    }
    __syncthreads();
}

__device__ __forceinline__ void transpose_item(const float* W, int K, int N, bf16* dst, LAS float* scr, int k0, int n0, int lane) {
#pragma unroll 8
    for (int i = 0; i < 32; ++i) { const int kk = 2 * i + (lane >> 5); scr[kk * 33 + (lane & 31)] = W[(size_t)(k0 + kk) * N + n0 + (lane & 31)]; }
    asm volatile("s_waitcnt lgkmcnt(0)" ::: "memory");
    const int c = lane & 7;
#pragma unroll
    for (int j = 0; j < 4; ++j) { const int n = (lane >> 3) + 8 * j; const LAS float* s = scr + (8 * c) * 33 + n;
        u32x4 o; o.x = pk2(s[0 * 33], s[1 * 33]); o.y = pk2(s[2 * 33], s[3 * 33]); o.z = pk2(s[4 * 33], s[5 * 33]); o.w = pk2(s[6 * 33], s[7 * 33]);
        *(u32x4*)(dst + (size_t)n * K + k0 + 8 * c) = o; }
    asm volatile("s_waitcnt lgkmcnt(0)" ::: "memory");
}
struct Ptrs {
    const float *x, *mem, *a_w_in, *b_w_in, *sgu_g, *sgu_b, *sgu_ws, *sgu_bs, *w_mkv, *w_out, *ln1g, *ln1b, *w_gate, *w_up, *w_down, *ln2g, *ln2b;
    float* out; unsigned char* ws;
};
typedef __attribute__((address_space(4))) const unsigned char* kargp_t;
template <class T> __device__ __forceinline__ T karg(kargp_t kp, int off) { return *(const volatile __attribute__((address_space(4))) T*)(kp + off); }
#define KP(field) karg<decltype(Ptrs::field)>(kp, (int)__builtin_offsetof(Ptrs, field))
__device__ __forceinline__ void prologue(kargp_t kp, LAS unsigned char* lds, int tid, int lane, int wave) {
    LAS float* scr = (LAS float*)(lds + wave * 16384);
    const int gw = blockIdx.x * NWAVES + wave, NGW = gridDim.x * NWAVES;
    constexpr int I_A = 16 * 80, I_B = 16 * 56, I_M = 16 * 16, I_O = 16 * 32, I_G = 16 * 88, I_D = 44 * 32;
    constexpr int C_A = 2 * I_A, C_B = C_A + 2 * I_B, C_M = C_B + 4 * I_M, C_O = C_M + 4 * I_O, C_G = C_O + 8 * I_G, C_D = C_G + 4 * I_D;
    unsigned char* ws = KP(ws);
    for (int it = gw; it < C_D; it += NGW) {
        if (it < C_A) { const int j = it / I_A, r = it % I_A, kb = r / 80, nb = r % 80;
            transpose_item(KP(a_w_in) + (size_t)j * D * INA, D, INA, (bf16*)(ws + WS_WINA) + ((size_t)j * INA + 32 * nb) * D, scr, 64 * kb, 32 * nb, lane); }
        else if (it < C_B) { const int q = it - C_A, j = q / I_B, r = q % I_B, kb = r / 56, nb = r % 56;
            transpose_item(KP(b_w_in) + (size_t)j * D * INB, D, INB, (bf16*)(ws + WS_WINB) + ((size_t)j * INB + 32 * nb) * D, scr, 64 * kb, 32 * nb, lane); }
        else if (it < C_M) { const int q = it - C_B, j = q / I_M, r = q % I_M, kb = r / 16, nb = r % 16;
            transpose_item(KP(w_mkv) + (size_t)j * D * 512, D, 512, (bf16*)(ws + WS_WMKV) + ((size_t)j * 512 + 32 * nb) * D, scr, 64 * kb, 32 * nb, lane); }
        else if (it < C_O) { const int q = it - C_M, j = q / I_O, r = q % I_O, kb = r / 32, nb = r % 32;
            transpose_item(KP(w_out) + (size_t)j * D * D, D, D, (bf16*)(ws + WS_WOUT) + ((size_t)j * D + 32 * nb) * D, scr, 64 * kb, 32 * nb, lane); }
        else if (it < C_G) { const int q = it - C_O, jj = q / I_G, r = q % I_G, kb = r / 88, nb = r % 88, j = jj >> 1, up = jj & 1;
            const int n0 = 32 * nb, drow = 256 * (n0 >> 7) + (n0 & 127) + 128 * up;
            transpose_item((up ? KP(w_up) : KP(w_gate)) + (size_t)j * D * FF, D, FF, (bf16*)(ws + WS_WFF) + ((size_t)j * FF2 + drow) * D, scr, 64 * kb, n0, lane); }
        else { const int q = it - C_G, j = q / I_D, r = q % I_D, kb = r / 32, nb = r % 32;
            transpose_item(KP(w_down) + (size_t)j * FF * D, FF, D, (bf16*)(ws + WS_WDN) + ((size_t)j * D + 32 * nb) * FF, scr, 64 * kb, 32 * nb, lane); }
    }
    const size_t gt = (size_t)blockIdx.x * NTHR + tid, NGT = (size_t)gridDim.x * NTHR;
    const float* sgu_ws = KP(sgu_ws);
    for (size_t i = gt; i < (size_t)2 * 12 * 128 * 128 / 8; i += NGT) { const size_t e = i * 8; const int s0 = (int)(e & 127), t = (int)((e >> 7) & 127);
        const f32x4 a = *(const f32x4*)(sgu_ws + e), b = *(const f32x4*)(sgu_ws + e + 4); float v[8] = {a.x, a.y, a.z, a.w, b.x, b.y, b.z, b.w};
#pragma unroll
        for (int k = 0; k < 8; ++k) v[k] = (s0 + k <= t) ? v[k] : 0.f;
        u32x4 o; o.x = pk2(v[0], v[1]); o.y = pk2(v[2], v[3]); o.z = pk2(v[4], v[5]); o.w = pk2(v[6], v[7]); *(u32x4*)((bf16*)(ws + WS_WS) + e) = o; }
    const float* xin = KP(x); const float* memin = KP(mem);
    for (size_t i = gt; i < (size_t)M * D / 8; i += NGT) { const f32x4 a = *(const f32x4*)(xin + i * 8), b = *(const f32x4*)(xin + i * 8 + 4);
        u32x4 o; o.x = pk2(a.x, a.y); o.y = pk2(a.z, a.w); o.z = pk2(b.x, b.y); o.w = pk2(b.z, b.w); *(u32x4*)((bf16*)(ws + WS_XB) + i * 8) = o; }
    for (size_t i = gt; i < (size_t)MMEM * D / 8; i += NGT) { const f32x4 a = *(const f32x4*)(memin + i * 8), b = *(const f32x4*)(memin + i * 8 + 4);
        u32x4 o; o.x = pk2(a.x, a.y); o.y = pk2(a.z, a.w); o.z = pk2(b.x, b.y); o.w = pk2(b.z, b.w); *(u32x4*)((bf16*)(ws + WS_MEMB) + i * 8) = o; }
}

__device__ __forceinline__ void ln_phase(float* xio, const float* g, const float* b, bf16* xb, int lane, int wave) {
    const int gw = blockIdx.x * NWAVES + wave, NGW = gridDim.x * NWAVES;
    constexpr int R = 4;
    for (int m0 = gw * R; m0 < M; m0 += NGW * R) {
        f32x4 v[R][4]; float s[R], mean[R], rstd[R];
#pragma unroll
        for (int r = 0; r < R; ++r) { const float* xr = xio + (size_t)(m0 + r) * D + 4 * lane;
#pragma unroll
            for (int j = 0; j < 4; ++j) v[r][j] = *(const f32x4*)(xr + 256 * j); }
#pragma unroll
        for (int r = 0; r < R; ++r) { s[r] = 0.f;
#pragma unroll
            for (int j = 0; j < 4; ++j) s[r] += (v[r][j].x + v[r][j].y) + (v[r][j].z + v[r][j].w); }
#pragma unroll
        for (int o = 1; o < 64; o <<= 1) {
#pragma unroll
            for (int r = 0; r < R; ++r) s[r] += __shfl_xor(s[r], o); }
#pragma unroll
        for (int r = 0; r < R; ++r) { mean[r] = s[r] * (1.f / D); s[r] = 0.f;
#pragma unroll
            for (int j = 0; j < 4; ++j) { v[r][j] = v[r][j] - mean[r]; s[r] += (v[r][j].x * v[r][j].x + v[r][j].y * v[r][j].y) + (v[r][j].z * v[r][j].z + v[r][j].w * v[r][j].w); } }
#pragma unroll
        for (int o = 1; o < 64; o <<= 1) {
#pragma unroll
            for (int r = 0; r < R; ++r) s[r] += __shfl_xor(s[r], o); }
#pragma unroll
        for (int r = 0; r < R; ++r) rstd[r] = 1.f / sqrtf(s[r] * (1.f / D) + LN_EPS);
#pragma unroll
        for (int j = 0; j < 4; ++j) { const f32x4 gv = *(const f32x4*)(g + 256 * j + 4 * lane), bv = *(const f32x4*)(b + 256 * j + 4 * lane);
#pragma unroll
            for (int r = 0; r < R; ++r) { const f32x4 y = v[r][j] * rstd[r] * gv + bv; *(f32x4*)(xio + (size_t)(m0 + r) * D + 256 * j + 4 * lane) = y;
                if (xb) { u32x2 o; o.x = pk2(y.x, y.y); o.y = pk2(y.z, y.w); *(u32x2*)(xb + (size_t)(m0 + r) * D + 256 * j + 4 * lane) = o; } } }
    }
}

constexpr int KROW = 144;
constexpr int ATT_K = 0, ATT_V = 256 * KROW;
template <int MODE>
__device__ __forceinline__ void attn_unit(LAS unsigned char* lds, const bf16* Qb, long qstride, const bf16* Kb, const bf16* Vb, long kvstride, int first_key, float slope2,
                                          bf16* Ob, long ostride, float* lse, long lsestride, int tid, int lane, int wave) {
    __syncthreads();
    {   u32x4 kq[4], vq[4];
#pragma unroll
        for (int i = 0; i < 4; ++i) { const int id = tid + NTHR * i, key = id >> 3, c = id & 7;
            if (key >= first_key) { kq[i] = *(const u32x4*)(Kb + (long)key * kvstride + c * 8); vq[i] = *(const u32x4*)(Vb + (long)key * kvstride + c * 8); } }
#pragma unroll
        for (int i = 0; i < 4; ++i) { const int id = tid + NTHR * i, key = id >> 3, c = id & 7;
            if (key >= first_key) { *(LAS u32x4*)(lds + ATT_K + key * KROW + c * 16) = kq[i]; *(LAS u32x4*)(lds + ATT_V + key * KROW + c * 16) = vq[i]; } }
    }
    const int i16 = lane & 15, quad = lane >> 4, qi = 16 * wave + i16;
    const bf16* qp = Qb + (long)qi * qstride + 8 * quad;
    const bf16x8 Q0 = *(const bf16x8*)qp, Q1 = *(const bf16x8*)(qp + 32);
    __syncthreads();
    const int kt_lo = (MODE == 0) ? ((wave > (first_key >> 4)) ? wave : (first_key >> 4)) : 0, kt_hi = (MODE == 0) ? wave + 8 : 15;
    float m_run = -1e30f, l_run = 0.f; f32x4 O[4];
#pragma unroll
    for (int dt = 0; dt < 4; ++dt) O[dt] = (f32x4){0.f, 0.f, 0.f, 0.f};
    const float scale = 0.125f * LOG2E;
    const LAS unsigned char* kbase = lds + ATT_K + i16 * KROW + 16 * quad;
    const LAS unsigned char* vbase = lds + ATT_V + (4 * quad + (i16 >> 2)) * KROW + 8 * (i16 & 3);
    for (int kp = kt_lo; kp <= kt_hi; kp += 2) {
        const int ta = kp; const bool hasb = (kp + 1 <= kt_hi); const int tb = hasb ? kp + 1 : kp;
        const bf16x8 ka0 = *(const LAS bf16x8*)(kbase + ta * 16 * KROW), ka1 = *(const LAS bf16x8*)(kbase + ta * 16 * KROW + 64);
        const bf16x8 kb0 = *(const LAS bf16x8*)(kbase + tb * 16 * KROW), kb1 = *(const LAS bf16x8*)(kbase + tb * 16 * KROW + 64);
        f32x4 sa = (f32x4){0.f, 0.f, 0.f, 0.f}, sb = (f32x4){0.f, 0.f, 0.f, 0.f};
        sa = __builtin_amdgcn_mfma_f32_16x16x32_bf16(ka0, Q0, sa, 0, 0, 0); sa = __builtin_amdgcn_mfma_f32_16x16x32_bf16(ka1, Q1, sa, 0, 0, 0);
        sb = __builtin_amdgcn_mfma_f32_16x16x32_bf16(kb0, Q0, sb, 0, 0, 0); sb = __builtin_amdgcn_mfma_f32_16x16x32_bf16(kb1, Q1, sb, 0, 0, 0);
        float s[8];
#pragma unroll
        for (int r = 0; r < 4; ++r) {
            if (MODE == 0) {
                const int sta = qi + 128 - (16 * ta + 4 * quad + r), stb = qi + 128 - (16 * tb + 4 * quad + r);
                s[r] = ((unsigned)sta <= 128u) ? sa[r] * scale - slope2 * (float)sta : -1e30f;
                s[4 + r] = (hasb && (unsigned)stb <= 128u) ? sb[r] * scale - slope2 * (float)stb : -1e30f;
            } else { s[r] = sa[r] * scale; s[4 + r] = sb[r] * scale; }
        }
        float mx = fmaxf(fmaxf(fmaxf(s[0], s[1]), fmaxf(s[2], s[3])), fmaxf(fmaxf(s[4], s[5]), fmaxf(s[6], s[7])));
        mx = fmaxf(mx, __shfl_xor(mx, 16)); mx = fmaxf(mx, __shfl_xor(mx, 32));
        const float m_new = fmaxf(m_run, mx), al = __builtin_amdgcn_exp2f(m_run - m_new);
        float p[8], ps = 0.f;
#pragma unroll
        for (int r = 0; r < 8; ++r) { p[r] = __builtin_amdgcn_exp2f(s[r] - m_new); ps += p[r]; }
        l_run = l_run * al + ps; m_run = m_new;
        bf16x8 pf; { u32x4 w; w.x = pk2(p[0], p[1]); w.y = pk2(p[2], p[3]); w.z = pk2(p[4], p[5]); w.w = pk2(p[6], p[7]); pf = __builtin_bit_cast(bf16x8, w); }
#pragma unroll
        for (int dt = 0; dt < 4; ++dt) {
            const s16x4 va = tr_read(vbase + ta * 16 * KROW + dt * 32), vb = tr_read(vbase + tb * 16 * KROW + dt * 32);
            O[dt] = O[dt] * al;
            O[dt] = __builtin_amdgcn_mfma_f32_16x16x32_bf16(cat4(va, vb), pf, O[dt], 0, 0, 0);
        }
    }
    float lt = l_run; lt += __shfl_xor(lt, 16); lt += __shfl_xor(lt, 32);
    const float inv = 1.0f / lt;
    bf16* op = Ob + (long)qi * ostride + 4 * quad;
#pragma unroll
    for (int dt = 0; dt < 4; ++dt) { u32x2 o; o.x = pk2(O[dt][0] * inv, O[dt][1] * inv); o.y = pk2(O[dt][2] * inv, O[dt][3] * inv); *(u32x2*)(op + 16 * dt) = o; }
    if (MODE == 0 && quad == 0) lse[(long)qi * lsestride] = m_run + __builtin_amdgcn_logf(lt);
}

__device__ __forceinline__ void dil_unit(int u, const bf16* H, unsigned char* ws, LAS unsigned char* lds, int tid, int lane, int wave) {
    const int j = u & 15, p = (u >> 4) % 3, bh = u / 48, h = bh % 12, b = bh / 12;
    const int lg = 2 * p, dil = 1 << lg, r = j & (dil - 1), n = j >> lg;
    const float slope = __builtin_amdgcn_exp2f(-8.0f * (float)(h + 1) / 12.0f);
    const long tok0 = (long)b * SEQ + (long)n * 128 * dil + r;
    const long ktok0 = tok0 - (long)128 * dil;
    const bf16* Qb = H + tok0 * INA + h * 64;
    const bf16* Kb = H + ktok0 * INA + DILW + h * 64;
    const bf16* Vb = H + ktok0 * INA + 2 * DILW + h * 64;
    bf16* part = (p == 0) ? (bf16*)(ws + WS_XB) : (bf16*)(ws + WS_PART) + (size_t)(p - 1) * M * DILW;
    float* lse = (float*)(ws + WS_LSE) + (size_t)p * M * 12;
    attn_unit<0>(lds, Qb, (long)dil * INA, Kb, Vb, (long)dil * INA, n == 0 ? 128 : 0, slope * (float)dil * LOG2E,
                 part + tok0 * DILW + h * 64, (long)dil * DILW, lse + tok0 * 12 + h, (long)dil * 12, tid, lane, wave);
}
__device__ __forceinline__ void mem_unit(int u, const bf16* H, int ldh, int qoff, int layer, unsigned char* ws, LAS unsigned char* lds, int tid, int lane, int wave) {
    const int hm = u & 3, qb = (u >> 2) & 15, b = u >> 6;
    const long tok0 = (long)b * SEQ + qb * 128;
    const bf16* Kb = (const bf16*)(ws + WS_MKV) + (long)b * NMEM * 2048 + layer * 512 + hm * 64;
    attn_unit<1>(lds, H + tok0 * ldh + qoff + hm * 64, ldh, Kb, Kb + 256, 2048, 0, 0.f,
                 (bf16*)(ws + WS_MIX) + tok0 * D + DILW + hm * 64, D, nullptr, 0, tid, lane, wave);
}
__device__ __forceinline__ void merge_phase(unsigned char* ws, int tid) {
    const size_t gt = (size_t)blockIdx.x * NTHR + tid, NGT = (size_t)gridDim.x * NTHR;
    const bf16* P0 = (const bf16*)(ws + WS_XB); const bf16* P1 = (const bf16*)(ws + WS_PART); const bf16* P2 = P1 + (size_t)M * DILW;
    const float* L = (const float*)(ws + WS_LSE); bf16* MIX = (bf16*)(ws + WS_MIX);
    for (size_t i = gt; i < (size_t)M * 96; i += NGT) { const size_t tok = i / 96; const int c8 = (int)(i % 96), h = c8 >> 3;
        const float l0 = L[tok * 12 + h], l1 = L[(size_t)M * 12 + tok * 12 + h], l2 = L[(size_t)2 * M * 12 + tok * 12 + h];
        const float mx = fmaxf(l0, fmaxf(l1, l2)); float w0 = __builtin_amdgcn_exp2f(l0 - mx), w1 = __builtin_amdgcn_exp2f(l1 - mx), w2 = __builtin_amdgcn_exp2f(l2 - mx);
        const float inv = 1.0f / (w0 + w1 + w2); w0 *= inv; w1 *= inv; w2 *= inv;
        const u32x4 a = *(const u32x4*)(P0 + tok * DILW + c8 * 8), b = *(const u32x4*)(P1 + tok * DILW + c8 * 8), c = *(const u32x4*)(P2 + tok * DILW + c8 * 8);
        u32x4 o;
#pragma unroll
        for (int k = 0; k < 4; ++k) { const float lo = w0 * bflo(a[k]) + w1 * bflo(b[k]) + w2 * bflo(c[k]), hi = w0 * bfhi(a[k]) + w1 * bfhi(b[k]) + w2 * bfhi(c[k]); o[k] = pk2(lo, hi); }
        *(u32x4*)(MIX + tok * D + c8 * 8) = o; }
}

constexpr int SGU_STAT = 0, SGU_VN = 1024, SGU_VNB = 128 * KROW;
__device__ __forceinline__ void sgu_unit(int u, int jl, const float* sgu_g, const float* sgu_b, const float* sgu_bs, unsigned char* ws, const bf16* H, LAS unsigned char* lds, int tid, int lane, int wave) {
    typedef float f32x2v __attribute__((ext_vector_type(2)));
    const long t0 = (long)u * 128;
    LAS f32x2v* ST = (LAS f32x2v*)(lds + SGU_STAT);
    __syncthreads();
    for (int tt = 0; tt < 16; ++tt) { const int t = 16 * wave + tt; const bf16* row = H + (t0 + t) * INB + DILW;
        const u32x4 a = *(const u32x4*)(row + 8 * lane); u32x4 b = (u32x4){0u, 0u, 0u, 0u}; if (lane < 32) b = *(const u32x4*)(row + 512 + 8 * lane);
        float s = 0.f;
#pragma unroll
        for (int k = 0; k < 4; ++k) s += bflo(a[k]) + bfhi(a[k]) + bflo(b[k]) + bfhi(b[k]);
        const float mean = wave_sum(s) * (1.f / 768.f); float q = 0.f;
#pragma unroll
        for (int k = 0; k < 4; ++k) { const float d0 = bflo(a[k]) - mean, d1 = bfhi(a[k]) - mean; q += d0 * d0 + d1 * d1; if (lane < 32) { const float d2 = bflo(b[k]) - mean, d3 = bfhi(b[k]) - mean; q += d2 * d2 + d3 * d3; } }
        const float rstd = 1.f / sqrtf(wave_sum(q) * (1.f / 768.f) + LN_EPS);
        if (lane == 0) ST[t] = (f32x2v){mean, rstd};
    }
    __syncthreads();
    const int i16 = lane & 15, quad = lane >> 4, t = 16 * wave + i16, nks = (wave >> 1) + 1;
    const float* lng = sgu_g + jl * DILW; const float* lnb = sgu_b + jl * DILW;
    for (int g = 0; g < 12; ++g) {
        LAS unsigned char* vn = lds + SGU_VN + (g & 1) * SGU_VNB;
#pragma unroll
        for (int i = 0; i < 2; ++i) { const int id = tid + NTHR * i, s = id >> 3, c = id & 7; const f32x2v st = ST[s];
            const u32x4 a = *(const u32x4*)(H + (t0 + s) * INB + DILW + g * 64 + c * 8);
            const f32x4 g0 = *(const f32x4*)(lng + g * 64 + c * 8), g1 = *(const f32x4*)(lng + g * 64 + c * 8 + 4), b0 = *(const f32x4*)(lnb + g * 64 + c * 8), b1 = *(const f32x4*)(lnb + g * 64 + c * 8 + 4);
            u32x4 o;
            o.x = pk2((bflo(a.x) - st.x) * st.y * g0.x + b0.x, (bfhi(a.x) - st.x) * st.y * g0.y + b0.y); o.y = pk2((bflo(a.y) - st.x) * st.y * g0.z + b0.z, (bfhi(a.y) - st.x) * st.y * g0.w + b0.w);
            o.z = pk2((bflo(a.z) - st.x) * st.y * g1.x + b1.x, (bfhi(a.z) - st.x) * st.y * g1.y + b1.y); o.w = pk2((bflo(a.w) - st.x) * st.y * g1.z + b1.z, (bfhi(a.w) - st.x) * st.y * g1.w + b1.w);
            *(LAS u32x4*)(vn + s * KROW + c * 16) = o; }
        __syncthreads();
        f32x4 acc[4];
#pragma unroll
        for (int ct = 0; ct < 4; ++ct) acc[ct] = (f32x4){0.f, 0.f, 0.f, 0.f};
        const bf16* wrow = (const bf16*)(ws + WS_WS) + ((size_t)(jl * 12 + g) * 128 + t) * 128 + 8 * quad;
        const LAS unsigned char* vb = vn + (8 * quad + (i16 >> 2)) * KROW + 8 * (i16 & 3);
        for (int ks = 0; ks < nks; ++ks) { const bf16x8 wf = *(const bf16x8*)(wrow + 32 * ks);
#pragma unroll
            for (int ct = 0; ct < 4; ++ct) { const s16x4 v0 = tr_read(vb + ks * 32 * KROW + ct * 32), v1 = tr_read(vb + ks * 32 * KROW + 4 * KROW + ct * 32);
                acc[ct] = __builtin_amdgcn_mfma_f32_16x16x32_bf16(cat4(v0, v1), wf, acc[ct], 0, 0, 0); } }
        const float bs = sgu_bs[(size_t)(jl * 12 + g) * 128 + t];
        const bf16* up = H + (t0 + t) * INB + g * 64 + 4 * quad; bf16* op = (bf16*)(ws + WS_MIX) + (t0 + t) * D + g * 64 + 4 * quad;
#pragma unroll
        for (int ct = 0; ct < 4; ++ct) { const u32x2 uu = *(const u32x2*)(up + 16 * ct);
            u32x2 o; o.x = pk2(bflo(uu.x) * (acc[ct][0] + bs), bfhi(uu.x) * (acc[ct][1] + bs)); o.y = pk2(bflo(uu.y) * (acc[ct][2] + bs), bfhi(uu.y) * (acc[ct][3] + bs));
            *(u32x2*)(op + 16 * ct) = o; }
    }
}

#ifndef MK_SPLIT
#define MK_SPLIT 0
#endif
#ifndef MK_DUP_MIX
#define MK_DUP_MIX 1
#endif
#ifndef MK_DUP_FF
#define MK_DUP_FF 1
#endif
#ifndef MK_DUP_SYNC
#define MK_DUP_SYNC 1
#endif
__global__ void __launch_bounds__(NTHR, 2) fwd_kernel(Ptrs Pdummy, int ph_lo_, int ph_hi_) {
    extern __shared__ __attribute__((aligned(16))) unsigned char lds_raw[];
    LAS unsigned char* lds = (LAS unsigned char*)lds_raw;
    const kargp_t kp = (kargp_t)__builtin_amdgcn_kernarg_segment_ptr();
    int phase = 0;
#if MK_SPLIT
    const int ph_lo = ph_lo_, ph_hi = ph_hi_;
#define SEAM() do { ++phase; } while (0)
#define RUN (phase >= ph_lo && phase < ph_hi)
#else
    cg::grid_group grid = cg::this_grid();
    if (threadIdx.x < 2) ((LAS unsigned*)(lds + 131072))[threadIdx.x] = 0u;
    __syncthreads();
    const XcdBarrier xbar = xcd_barrier_post((unsigned*)KP(ws), (volatile LAS unsigned*)(lds + 131072));
#define SEAM() do { for (int r_ = 0; r_ < MK_DUP_SYNC; ++r_) xcd_barrier(xbar); } while (0)
#define RUN true
#endif
#define WSP(off) (KP(ws) + (off))
    if (RUN) { TIDS(); prologue(kp, lds, tid, lane, wave); }
#if MK_SPLIT
    SEAM();
#else
    grid.sync();
#endif
    if (RUN) {
        unsigned char* ws = KP(ws);
        pg8::Gemm g{(const bf16*)(ws + WS_MEMB), (const bf16*)(ws + WS_WMKV), MMEM, 2048, D}; pg8::StaticOrder S; S.init(MMEM, 2048, (int)gridDim.x, (int)blockIdx.x);
        pg8::EpiStore E{(bf16*)(ws + WS_MKV), 2048, 0};
        pg8::gemm_phase<pg8::EpiStore, pg8::StaticOrder, true, true>(lds, g, S, E);
    }
#pragma unroll 1
    for (int layer = 0; layer < DEPTH; ++layer) {
        const int jl = layer >> 1; const bool isA = (layer & 1) == 0;
        if (RUN) {
            unsigned char* ws = KP(ws); const int ldh = isA ? INA : INB;
            pg8::Gemm g{(const bf16*)(ws + WS_XB), isA ? (const bf16*)(ws + WS_WINA) + (size_t)jl * INA * D : (const bf16*)(ws + WS_WINB) + (size_t)jl * INB * D, M, ldh, D};
            pg8::StaticOrder S; S.init(M, ldh, (int)gridDim.x, (int)blockIdx.x);
            pg8::EpiStore E{(bf16*)(ws + WS_H), ldh, isA ? 0 : 6};
            pg8::gemm_phase<pg8::EpiStore, pg8::StaticOrder, true, true>(lds, g, S, E);
        }
        SEAM();
        for (int rep_ = 0; rep_ < MK_DUP_MIX; ++rep_) {
        if (rep_) SEAM();
        if (isA) {
            if (RUN) {
                unsigned char* ws = KP(ws); const bf16* H = (const bf16*)(ws + WS_H);
                for (int u = blockIdx.x; u < 18432 + 2048; u += gridDim.x) { TIDS();
                    if (u < 18432) dil_unit(u, H, ws, lds, tid, lane, wave); else mem_unit(u - 18432, H, INA, 3 * DILW, layer, ws, lds, tid, lane, wave);
                }
            }
            SEAM();
            if (RUN) { TIDS(); (void)lane; (void)wave; merge_phase(KP(ws), tid); }
        } else {
            if (RUN) {
                unsigned char* ws = KP(ws); const bf16* H = (const bf16*)(ws + WS_H);
                const float* sg = KP(sgu_g); const float* sb = KP(sgu_b); const float* sbs = KP(sgu_bs);
                for (int u = blockIdx.x; u < 512 + 2048; u += gridDim.x) { TIDS();
                    if (u < 512) sgu_unit(u, jl, sg, sb, sbs, ws, H, lds, tid, lane, wave); else mem_unit(u - 512, H, INB, 2 * DILW, layer, ws, lds, tid, lane, wave);
                }
            }
        }
        }
        SEAM();
        if (RUN) {
            __syncthreads();
            unsigned char* ws = KP(ws); float* out = KP(out); const float* base = (layer == 0) ? KP(x) : (const float*)out;
            pg8::Gemm g{(const bf16*)(ws + WS_MIX), (const bf16*)(ws + WS_WOUT) + (size_t)layer * D * D, M, D, D}; pg8::StaticOrder S; S.init(M, D, (int)gridDim.x, (int)blockIdx.x);
            pg8::EpiResid E{base, out, D, DN_ALPHA};
            pg8::gemm_phase<pg8::EpiResid, pg8::StaticOrder, true, true>(lds, g, S, E);
        }
        SEAM();
        if (RUN) { TIDS(); (void)tid; ln_phase(KP(out), KP(ln1g) + layer * D, KP(ln1b) + layer * D, (bf16*)WSP(WS_XB), lane, wave); }
        SEAM();
        for (int rep_ = 0; rep_ < MK_DUP_FF; ++rep_)
        if (RUN) {
            unsigned char* ws = KP(ws);
            pg8::Gemm g{(const bf16*)(ws + WS_XB), (const bf16*)(ws + WS_WFF) + (size_t)layer * FF2 * D, M, FF2, D}; pg8::StaticOrder S; S.init(M, FF2, (int)gridDim.x, (int)blockIdx.x);
            pg8::EpiSwiGLU E{(bf16*)(ws + WS_H), FF};
            pg8::gemm_phase<pg8::EpiSwiGLU, pg8::StaticOrder, true, true>(lds, g, S, E);
        }
        SEAM();
        if (RUN) {
            unsigned char* ws = KP(ws); float* out = KP(out);
            pg8::Gemm g{(const bf16*)(ws + WS_H), (const bf16*)(ws + WS_WDN) + (size_t)layer * D * FF, M, D, FF}; pg8::StaticOrder S; S.init(M, D, (int)gridDim.x, (int)blockIdx.x);
            pg8::EpiResid E{out, out, D, DN_ALPHA};
            pg8::gemm_phase<pg8::EpiResid, pg8::StaticOrder, true, true>(lds, g, S, E);
        }
        SEAM();
        if (RUN) { TIDS(); (void)tid; ln_phase(KP(out), KP(ln2g) + layer * D, KP(ln2b) + layer * D, layer + 1 < DEPTH ? (bf16*)WSP(WS_XB) : nullptr, lane, wave); }
        if (layer + 1 < DEPTH) SEAM();
    }
}

extern "C" void kernel_launch(void* const* d_in, const int* in_sizes, int n_in, void* d_out, int out_size, void* d_ws, size_t ws_size, hipStream_t stream) {
    static int grid = 0;
    if (grid == 0) {
        if (n_in != 17 || out_size != M * D || ws_size < WS_END) { fprintf(stderr, "kernel_launch: unexpected shapes (n_in %d out %d ws %zu)\n", n_in, out_size, ws_size); grid = -1; return; }
        int dev = 0, cus = 0, per_cu = 0;
        hipGetDevice(&dev); hipDeviceGetAttribute(&cus, hipDeviceAttributeMultiprocessorCount, dev);
        if (hipFuncSetAttribute((const void*)fwd_kernel, hipFuncAttributeMaxDynamicSharedMemorySize, LDS_BYTES) != hipSuccess) { fprintf(stderr, "kernel_launch: hipFuncSetAttribute failed\n"); grid = -1; return; }
        hipOccupancyMaxActiveBlocksPerMultiprocessor(&per_cu, (const void*)fwd_kernel, NTHR, LDS_BYTES);
        (void)hipGetLastError();
        if (per_cu < 1) per_cu = 1;
        grid = cus * per_cu;
        fprintf(stderr, "kernel_launch: grid %d (cus %d x %d)\n", grid, cus, per_cu);
    }
    if (grid < 0) return;
    Ptrs p{};
    p.x = (const float*)d_in[0]; p.mem = (const float*)d_in[1]; p.a_w_in = (const float*)d_in[2]; p.b_w_in = (const float*)d_in[3];
    p.sgu_g = (const float*)d_in[4]; p.sgu_b = (const float*)d_in[5]; p.sgu_ws = (const float*)d_in[6]; p.sgu_bs = (const float*)d_in[7];
    p.w_mkv = (const float*)d_in[8]; p.w_out = (const float*)d_in[9]; p.ln1g = (const float*)d_in[10]; p.ln1b = (const float*)d_in[11];
    p.w_gate = (const float*)d_in[12]; p.w_up = (const float*)d_in[13]; p.w_down = (const float*)d_in[14]; p.ln2g = (const float*)d_in[15]; p.ln2b = (const float*)d_in[16];
    p.out = (float*)d_out; p.ws = (unsigned char*)d_ws;
#if MK_SPLIT
    for (int ph = 0; ph < 64; ++ph) { int lo = ph, hi = ph + 1; hipLaunchKernelGGL(fwd_kernel, dim3(grid), dim3(NTHR), LDS_BYTES, stream, p, lo, hi); }
#else
    int lo = 0, hi = 1 << 30;
    if (hipMemsetAsync(d_ws, 0, 16384, stream) != hipSuccess) { fprintf(stderr, "kernel_launch: memset of the barrier words failed\n"); return; }
    void* args[] = {&p, &lo, &hi};
    hipError_t e = hipLaunchCooperativeKernel((const void*)fwd_kernel, dim3(grid), dim3(NTHR), args, LDS_BYTES, stream);
    if (e != hipSuccess) fprintf(stderr, "cooperative launch failed: %s (grid %d)\n", hipGetErrorString(e), grid);
#endif
}
```
